# Optimizing an MI355X kernel written in HIP

```python
import math
import jax, jax.numpy as jnp
from jax import lax
import numpy as np

D_MODEL = 2048
BATCH = 8
SEQ = 2048
DEPTH = 2
DEC_BATCH = 4
DEC_SEQ = 4096
PAST_LEN = 128

HEAD_DIM = 64
RET_HEADS = 8
RET_W = RET_HEADS * HEAD_DIM
RET_CHUNK = 128
NA_HEADS = 12
NA_W = NA_HEADS * HEAD_DIM
GRID_W = 64
NA_KH_MAX = 8
NA_KW = 16
NA_QB = 16
NA_HALO = NA_QB + NA_KW
DIFF_HEADS = 6
DIFF_QK_DIM = HEAD_DIM
DIFF_V_DIM = 2 * HEAD_DIM
DIFF_W = DIFF_HEADS * DIFF_V_DIM
DIFF_QBLOCK = 128
D_MIX = RET_W + NA_W + DIFF_W
D_IN = 4 * RET_W + 3 * NA_W + 3 * DIFF_W
D_FF = 5632
CONV_W = 3
NORM_EPS = 1e-6
NEG_INF = -1e30

kernel_name = 'hybrid_bidir_encoder'


def rms_norm(x, w):
    xf = x.astype(jnp.float32)
    y = xf * lax.rsqrt(jnp.mean(xf * xf, axis=-1, keepdims=True) + NORM_EPS)
    return (y * w.astype(jnp.float32)).astype(x.dtype)


def head_norm(x, w, center):
    xf = x.astype(jnp.float32)
    if center:
        xf = xf - jnp.mean(xf, axis=-1, keepdims=True)
    y = xf * lax.rsqrt(jnp.mean(xf * xf, axis=-1, keepdims=True) + NORM_EPS)
    return y.reshape(x.shape[:-2] + (-1,)) * w.astype(jnp.float32)


def retention_scan(q, k, v, log_gamma, include_diag):
    B, S, H, d = q.shape
    n = S // RET_CHUNK

    def chunks(t):
        return t.reshape(B, n, RET_CHUNK, H, d).transpose(1, 0, 3, 2, 4)

    pos = jnp.arange(RET_CHUNK, dtype=jnp.float32)
    delta = pos[:, None] - pos[None, :]
    lower = (delta >= 0) if include_diag else (delta > 0)
    lg = log_gamma[:, None, None]
    decay_in = jnp.where(lower[None], jnp.exp(lg * jnp.maximum(delta, 0.0)[None]), 0.0)
    q_decay = jnp.exp(log_gamma[:, None] * (pos + 1.0)[None])[..., None]
    k_decay = jnp.exp(log_gamma[:, None] * (RET_CHUNK - 1.0 - pos)[None])[..., None]
    chunk_decay = jnp.exp(log_gamma * RET_CHUNK)[:, None, None]

    def step(state, qkv):
        qc, kc, vc = qkv
        inner = jnp.einsum('bhid,bhjd->bhij', qc, kc) * decay_in
        out = (jnp.einsum('bhij,bhje->bhie', inner, vc)
               + jnp.einsum('bhid,bhde->bhie', qc * q_decay, state))
        state = state * chunk_decay + jnp.einsum('bhjd,bhje->bhde', kc * k_decay, vc)
        return state, out

    state0 = jnp.zeros((B, H, d, d), jnp.float32)
    _, out = lax.scan(step, state0, (chunks(q), chunks(k), chunks(v)))
    return out.transpose(1, 0, 3, 2, 4).reshape(B, S, H, d)


def retention_mixer(q, k, v, g, decay_fwd, decay_bwd, norm_w):
    B, S = q.shape[:2]
    qf = q.reshape(B, S, RET_HEADS, HEAD_DIM).astype(jnp.float32)
    kf = k.reshape(B, S, RET_HEADS, HEAD_DIM).astype(jnp.float32) * (HEAD_DIM ** -0.5)
    vf = v.reshape(B, S, RET_HEADS, HEAD_DIM).astype(jnp.float32)
    lg_f = jax.nn.log_sigmoid(decay_fwd.astype(jnp.float32))
    lg_b = jax.nn.log_sigmoid(decay_bwd.astype(jnp.float32))
    fwd = retention_scan(qf, kf, vf, lg_f, True)
    bwd = jnp.flip(retention_scan(jnp.flip(qf, 1), jnp.flip(kf, 1), jnp.flip(vf, 1), lg_b, False), 1)
    y = head_norm(fwd + bwd, norm_w, True)
    return (jax.nn.silu(g.astype(jnp.float32)) * y).astype(g.dtype)


def neighbourhood_attention(q, k, v, rpb):
    B, S = q.shape[:2]
    rows = S // GRID_W
    kh = min(NA_KH_MAX, rows)
    ncb = GRID_W // NA_QB
    qg = q.reshape(B, rows, ncb, NA_QB, NA_HEADS, HEAD_DIM)
    q_rows = jnp.moveaxis(qg, 1, 0)
    kg = k.reshape(B, rows, GRID_W, NA_HEADS, HEAD_DIM)
    vg = v.reshape(B, rows, GRID_W, NA_HEADS, HEAD_DIM)
    blk = np.arange(ncb)
    cb = np.clip(blk * NA_QB - NA_KW // 2, 0, GRID_W - NA_HALO)
    col_idx = cb[:, None] + np.arange(NA_HALO)[None, :]
    qcol = blk[:, None] * NA_QB + np.arange(NA_QB)[None, :]
    cs = np.clip(qcol - NA_KW // 2, 0, GRID_W - NA_KW)
    kcol = col_idx[:, None, :]
    in_win = (kcol >= cs[..., None]) & (kcol < cs[..., None] + NA_KW)
    dc_idx = np.clip(kcol - qcol[..., None] + NA_KW - 1, 0, 2 * NA_KW - 2)
    rpb_cols = rpb.astype(jnp.float32)[:, :, dc_idx]
    mask = jnp.asarray(in_win)[None, None, :, :, None, :]
    scale = HEAD_DIM ** -0.5

    def row(args):
        q_row, r = args
        rs = jnp.clip(r - kh // 2, 0, rows - kh)
        k_blk = lax.dynamic_slice_in_dim(kg, rs, kh, axis=1)[:, :, col_idx]
        v_blk = lax.dynamic_slice_in_dim(vg, rs, kh, axis=1)[:, :, col_idx]
        s = jnp.einsum('bnqhd,bknjhd->bhnqkj', q_row, k_blk).astype(jnp.float32) * scale
        dr_idx = rs + jnp.arange(kh) - r + NA_KH_MAX - 1
        bias = rpb_cols[:, dr_idx].transpose(0, 2, 3, 1, 4)
        s = jnp.where(mask, s + bias[None], NEG_INF)
        p = jax.nn.softmax(s.reshape(B, NA_HEADS, ncb, NA_QB, kh * NA_HALO), axis=-1)
        p = p.reshape(B, NA_HEADS, ncb, NA_QB, kh, NA_HALO).astype(v.dtype)
        return jnp.einsum('bhnqkj,bknjhd->bnqhd', p, v_blk)

    out = lax.map(row, (q_rows, jnp.arange(rows)))
    return jnp.moveaxis(out, 0, 1).reshape(B, S, NA_W)


def diff_attention(q, k, v, lam, lam_init, norm_w):
    B, S = q.shape[:2]
    qh = q.reshape(B, S, DIFF_HEADS, 2, DIFF_QK_DIM)
    kh = k.reshape(B, S, DIFF_HEADS, 2, DIFF_QK_DIM)
    vh = v.reshape(B, S, DIFF_HEADS, DIFF_V_DIM)
    scale = DIFF_QK_DIM ** -0.5
    slopes = 2.0 ** (-8.0 * (jnp.arange(DIFF_HEADS, dtype=jnp.float32) + 1.0) / DIFF_HEADS)
    nb = S // DIFF_QBLOCK
    q_blocks = qh.reshape(B, nb, DIFF_QBLOCK, DIFF_HEADS, 2, DIFF_QK_DIM).transpose(1, 0, 2, 3, 4, 5)
    kpos = jnp.arange(S, dtype=jnp.float32)

    def block(args):
        q_blk, start = args
        qpos = start.astype(jnp.float32) + jnp.arange(DIFF_QBLOCK, dtype=jnp.float32)
        bias = -slopes[:, None, None] * jnp.abs(qpos[:, None] - kpos[None, :])
        s = jnp.einsum('bqhcd,bkhcd->bhcqk', q_blk, kh).astype(jnp.float32) * scale + bias[None, :, None]
        p = jax.nn.softmax(s, axis=-1)
        a = p[:, :, 0] - lam * p[:, :, 1]
        return jnp.einsum('bhqk,bkhe->bqhe', a.astype(v.dtype), vh)

    out = lax.map(block, (q_blocks, jnp.arange(nb) * DIFF_QBLOCK))
    out = out.transpose(1, 0, 2, 3, 4).reshape(B, S, DIFF_HEADS, DIFF_V_DIM)
    return (head_norm(out, norm_w, False) * (1.0 - lam_init)).astype(v.dtype)


def conv_ffn(h, w_up, conv_w, conv_b, w_down):
    u = h @ w_up
    a, g = jnp.split(u, 2, axis=-1)
    gp = jnp.pad(g, ((0, 0), (1, 1), (0, 0)))
    g = gp[:, :-2] * conv_w[0] + gp[:, 1:-1] * conv_w[1] + gp[:, 2:] * conv_w[2] + conv_b
    return (jax.nn.gelu(g) * a) @ w_down


def encoder_trunk(x, norm1_w, w_in, ret_decay_fwd, ret_decay_bwd, ret_norm_w, na_rpb,
                  diff_lambda_q1, diff_lambda_k1, diff_lambda_q2, diff_lambda_k2, diff_norm_w,
                  w_out, norm2_w, ffn_w_up, ffn_conv_w, ffn_conv_b, ffn_w_down, final_norm_w):
    splits = list(np.cumsum([RET_W] * 4 + [NA_W] * 3 + [DIFF_W] * 3)[:-1])
    for l in range(DEPTH):
        h = rms_norm(x, norm1_w[l])
        proj = h @ w_in[l]
        rq, rk, rv, rg, nq, nk, nv, dq, dk, dv = jnp.split(proj, splits, axis=-1)
        ret_out = retention_mixer(rq, rk, rv, rg, ret_decay_fwd[l], ret_decay_bwd[l], ret_norm_w[l])
        na_out = neighbourhood_attention(nq, nk, nv, na_rpb[l])
        lam_init = 0.8 - 0.6 * math.exp(-0.3 * l)
        lam = (jnp.exp(jnp.sum(diff_lambda_q1[l].astype(jnp.float32) * diff_lambda_k1[l].astype(jnp.float32)))
               - jnp.exp(jnp.sum(diff_lambda_q2[l].astype(jnp.float32) * diff_lambda_k2[l].astype(jnp.float32)))
               + lam_init)
        diff_out = diff_attention(dq, dk, dv, lam, lam_init, diff_norm_w[l])
        mix = jnp.concatenate([ret_out, na_out.astype(x.dtype), diff_out], axis=-1)
        x = x + mix @ w_out[l]
        h = rms_norm(x, norm2_w[l])
        x = x + conv_ffn(h, ffn_w_up[l], ffn_conv_w[l], ffn_conv_b[l], ffn_w_down[l])
    return rms_norm(x, final_norm_w)


def setup_inputs(seed: int = 0) -> dict:
    key = jax.random.key(seed)
    ks = jax.random.split(key, 20)
    f32 = jnp.float32

    def nrm(k, shape, scale):
        return jax.random.normal(k, shape, f32) * scale

    def gain(k, shape):
        return 1.0 + nrm(k, shape, 0.01)

    decay_init = jnp.asarray(np.log(2.0 ** (5 + np.arange(RET_HEADS)) - 1.0), f32)
    return {
        'x_prompt': nrm(ks[0], (BATCH, SEQ, D_MODEL), 1.0),
        'x_sample': nrm(ks[1], (DEC_BATCH, DEC_SEQ, D_MODEL), 1.0),
        'norm1_w': gain(ks[2], (DEPTH, D_MODEL)),
        'w_in': nrm(ks[3], (DEPTH, D_MODEL, D_IN), D_MODEL ** -0.5),
        'ret_decay_fwd': decay_init + nrm(ks[4], (DEPTH, RET_HEADS), 0.01),
        'ret_decay_bwd': decay_init + nrm(ks[5], (DEPTH, RET_HEADS), 0.01),
        'ret_norm_w': gain(ks[6], (DEPTH, RET_W)),
        'na_rpb': nrm(ks[7], (DEPTH, NA_HEADS, 2 * NA_KH_MAX - 1, 2 * NA_KW - 1), 0.02),
        'diff_lambda_q1': nrm(ks[8], (DEPTH, DIFF_QK_DIM), 0.1),
        'diff_lambda_k1': nrm(ks[9], (DEPTH, DIFF_QK_DIM), 0.1),
        'diff_lambda_q2': nrm(ks[10], (DEPTH, DIFF_QK_DIM), 0.1),
        'diff_lambda_k2': nrm(ks[11], (DEPTH, DIFF_QK_DIM), 0.1),
        'diff_norm_w': gain(ks[12], (DEPTH, DIFF_W)),
        'w_out': nrm(ks[13], (DEPTH, D_MIX, D_MODEL), D_MIX ** -0.5),
        'norm2_w': gain(ks[14], (DEPTH, D_MODEL)),
        'ffn_w_up': nrm(ks[15], (DEPTH, D_MODEL, 2 * D_FF), D_MODEL ** -0.5),
        'ffn_conv_w': nrm(ks[16], (DEPTH, CONV_W, D_FF), CONV_W ** -0.5),
        'ffn_conv_b': nrm(ks[17], (DEPTH, D_FF), 0.01),
        'ffn_w_down': nrm(ks[18], (DEPTH, D_FF, D_MODEL), D_FF ** -0.5),
        'final_norm_w': gain(ks[19], (D_MODEL,)),
    }


def reference(x_prompt, x_sample, norm1_w, w_in, ret_decay_fwd, ret_decay_bwd, ret_norm_w, na_rpb,
              diff_lambda_q1, diff_lambda_k1, diff_lambda_q2, diff_lambda_k2, diff_norm_w,
              w_out, norm2_w, ffn_w_up, ffn_conv_w, ffn_conv_b, ffn_w_down, final_norm_w):
    y_prompt = encoder_trunk(x_prompt, norm1_w, w_in, ret_decay_fwd, ret_decay_bwd, ret_norm_w, na_rpb,
                             diff_lambda_q1, diff_lambda_k1, diff_lambda_q2, diff_lambda_k2, diff_norm_w,
                             w_out, norm2_w, ffn_w_up, ffn_conv_w, ffn_conv_b, ffn_w_down, final_norm_w)
    y_sample = encoder_trunk(x_sample, norm1_w, w_in, ret_decay_fwd, ret_decay_bwd, ret_norm_w, na_rpb,
                             diff_lambda_q1, diff_lambda_k1, diff_lambda_q2, diff_lambda_k2, diff_norm_w,
                             w_out, norm2_w, ffn_w_up, ffn_conv_w, ffn_conv_b, ffn_w_down, final_norm_w)
    return (y_prompt, y_sample)
```

```cpp
#include <hip/hip_runtime.h>
#include <cstdio>
#include <cstdint>

__device__ __forceinline__ int lane_id_now() { int ln; asm volatile("v_mbcnt_lo_u32_b32 %0, -1, 0\n\tv_mbcnt_hi_u32_b32 %0, -1, %0" : "=v"(ln)); return ln; }
namespace pg8 {
#define PG8_LAS __attribute__((address_space(3)))
typedef unsigned short bf16_t;
typedef short bf16x8 __attribute__((ext_vector_type(8)));
typedef float f32x4 __attribute__((ext_vector_type(4)));
typedef unsigned u32x4 __attribute__((ext_vector_type(4)));
constexpr int BM = 256, BK = 64, HALF = 128, HTB = HALF * BK * 2  , STAGE_BYTES = 8 * HTB, NXCD = 8, WGM = 8;

__host__ __device__ __forceinline__ int lds_byte(int r, int c) { const int st = (r >> 4) * 2 + (c >> 5), rr = r & 15, cc = c & 31, ob = rr * 64 + cc * 2; return st * 1024 + (ob ^ (((ob >> 9) & 1) << 5)); }
__host__ __device__ __forceinline__ void stage_rc(int b, int& R, int& C) { const int st = b / 1024, sb = b % 1024, swz = sb ^ (((sb >> 9) & 1) << 5); R = (st >> 1) * 16 + swz / 64; C = (st & 1) * 32 + (swz % 64) / 2; }
__host__ __device__ __forceinline__ int perm32(int rho) { const int n = rho >> 4, i = rho & 15; return 8 * (i >> 2) + 4 * n + (i & 3); }

struct Unit { int pm, pn; };
struct Gemm { const bf16_t* A; const bf16_t* Bt; int M, N, K; };

struct StaticOrder {
    int nM, nN, nwg, G, c;
    __host__ __device__ void init(int M, int N, int G_, int c_) { nM = M / BM; nN = N / BM; nwg = nM * nN; G = G_; c = c_; }
    __host__ __device__ bool next(int i, Unit& u) const {
        const long L = (long)i * G + c; if (L >= nwg) return false;
        int wgid = (int)L; { const int q = nwg / NXCD, r = nwg % NXCD, xcd = wgid % NXCD, off = wgid / NXCD; wgid = (xcd < r ? xcd * (q + 1) : r * (q + 1) + (xcd - r) * q) + off; }
        const int nig = WGM * nN, gid = wgid / nig, fm = gid * WGM, gsz = (nM - fm) < WGM ? (nM - fm) : WGM;
        u.pm = fm + ((wgid % nig) % gsz); u.pn = (wgid % nig) / gsz; return true;
    }
    __device__ __forceinline__ void a_ready(const Unit&) const {}
    __device__ __forceinline__ void done(const Unit&) const {}
};

__device__ __forceinline__ unsigned cvt_pk_bf16(float lo, float hi) { unsigned r; asm volatile("v_cvt_pk_bf16_f32 %0, %1, %2" : "=v"(r) : "v"(lo), "v"(hi)); return r; }

template <class Epi, class Sched, bool ALIGN_EPI = false, bool SP2 = false>
__device__ __forceinline__ void gemm_phase(PG8_LAS unsigned char* lds, const Gemm g, const Sched& S, const Epi& E, int wave_id) {
    int tid_ = wave_id * 64 + lane_id_now();
    const int tid = tid_, wid = __builtin_amdgcn_readfirstlane(tid >> 6), lane = tid & 63, wr = wid >> 2, wc = wid & 3, fr = lane & 15, fq = lane >> 4;
    const int K = g.K, nt = K / BK;
    unsigned voffA[2], voffB[2];
#pragma unroll
    for (int i = 0; i < 2; ++i) { int R, C; stage_rc(tid * 16 + i * 8192, R, C); const int Rb = Epi::PERM ? ((R & ~31) + perm32(R & 31)) : R;
        voffA[i] = (unsigned)(R * K + C) * 2u; voffB[i] = (unsigned)(Rb * K + C) * 2u; }
    const size_t kstep = (size_t)(BK * 2);
    const size_t hstep = (size_t)HALF * K * 2;
    const size_t tstep = 2 * hstep;
    const unsigned ldsw = (unsigned)wid * 1024u;
    const int aoff = lds_byte(wr * 64 + fr, fq * 8), boff = lds_byte(wc * 32 + fr, fq * 8);
#define PG8_SA(b, h) (((b) * 2 + (h)) * HTB)
#define PG8_SB(b, h) ((4 + (b) * 2 + (h)) * HTB)
#define PG8_STAGE(bufoff, gbase, voff) do { _Pragma("unroll") for (int _i = 0; _i < 2; ++_i) \
        __builtin_amdgcn_global_load_lds((const unsigned*)((const char*)(gbase) + (voff)[_i]), (PG8_LAS unsigned*)(lds + (bufoff) + ldsw + _i * 8192), 16, 0, 0); } while (0)
#define PG8_LDA(dst, b, h) do { _Pragma("unroll") for (int m = 0; m < 4; ++m) _Pragma("unroll") for (int k = 0; k < 2; ++k) dst[m][k] = *(const PG8_LAS bf16x8*)(lds + PG8_SA(b, h) + aoff + m * 2048 + k * 1024); } while (0)
#define PG8_LDB(dst, b, h) do { _Pragma("unroll") for (int n = 0; n < 2; ++n) _Pragma("unroll") for (int k = 0; k < 2; ++k) dst[n][k] = *(const PG8_LAS bf16x8*)(lds + PG8_SB(b, h) + boff + n * 2048 + k * 1024); } while (0)
#define PG8_MMA(ai, bj, At, Bt) do { __builtin_amdgcn_s_setprio(1); _Pragma("unroll") for (int m = 0; m < 4; ++m) _Pragma("unroll") for (int n = 0; n < 2; ++n) _Pragma("unroll") for (int k = 0; k < 2; ++k) \
        acc[ai][bj][m][n] = __builtin_amdgcn_mfma_f32_16x16x32_bf16(Bt[n][k], At[m][k], acc[ai][bj][m][n], 0, 0, 0); __builtin_amdgcn_s_setprio(0); } while (0)
#define PG8_WAIT_V(n) asm volatile("s_waitcnt vmcnt(" #n ")" ::: "memory")
#define PG8_WAIT_L(n) asm volatile("s_waitcnt lgkmcnt(" #n ")" ::: "memory")
#define PG8_BAR __builtin_amdgcn_s_barrier()
#define PG8_SCHED __builtin_amdgcn_sched_barrier(0)
    Unit cur, nxt; int ui = 0;
    if (!S.next(0, cur)) return;
    f32x4 acc[2][2][4][2];
#pragma unroll
    for (int a = 0; a < 2; ++a)
#pragma unroll
        for (int b = 0; b < 2; ++b)
#pragma unroll
            for (int m = 0; m < 4; ++m)
#pragma unroll
                for (int n = 0; n < 2; ++n) acc[a][b][m][n] = (f32x4){0.f, 0.f, 0.f, 0.f};
    bf16x8 At[4][2], B0[2][2], B1[2][2];
    const char* cA = (const char*)g.A + (size_t)cur.pm * tstep; const char* cB = (const char*)g.Bt + (size_t)cur.pn * tstep;
    S.a_ready(cur);
    if constexpr (SP2) {
        PG8_STAGE(PG8_SB(0, 0), cB, voffB); PG8_STAGE(PG8_SB(0, 1), cB + hstep, voffB); PG8_STAGE(PG8_SA(0, 0), cA, voffA); PG8_STAGE(PG8_SA(0, 1), cA + hstep, voffA);
        if (wr == 1) PG8_BAR;
        PG8_WAIT_V(2); PG8_BAR;
        PG8_STAGE(PG8_SB(1, 0), cB + kstep, voffB); PG8_STAGE(PG8_SA(1, 0), cA + kstep, voffA); PG8_STAGE(PG8_SB(1, 1), cB + hstep + kstep, voffB);
        PG8_WAIT_V(6); PG8_BAR;
    } else {
        PG8_STAGE(PG8_SB(0, 0), cB, voffB); PG8_STAGE(PG8_SA(0, 0), cA, voffA); PG8_STAGE(PG8_SB(0, 1), cB + hstep, voffB); PG8_STAGE(PG8_SA(0, 1), cA + hstep, voffA);
        if (wr == 1) PG8_BAR;
        PG8_WAIT_V(4); PG8_BAR;
        PG8_STAGE(PG8_SB(1, 0), cB + kstep, voffB); PG8_STAGE(PG8_SA(1, 0), cA + kstep, voffA); PG8_STAGE(PG8_SB(1, 1), cB + hstep + kstep, voffB);
        PG8_WAIT_V(6); PG8_BAR;
    }
    for (;;) {
        const bool has_next = S.next(ui + 1, nxt);
        const char* nA = has_next ? (const char*)g.A + (size_t)nxt.pm * tstep : cA; const char* nB = has_next ? (const char*)g.Bt + (size_t)nxt.pn * tstep : cB;
        for (int t = 0; t < nt; t += 2) {
            const bool last = (t == nt - 2);
            const char* a1 = cA + (size_t)(t + 1) * kstep;
            const char* a2 = last ? nA : cA + (size_t)(t + 2) * kstep; const char* b2 = last ? nB : cB + (size_t)(t + 2) * kstep;
            const char* a3 = a2 + kstep; const char* b3 = b2 + kstep;
            if (last && has_next) S.a_ready(nxt);
            if constexpr (SP2) {
            PG8_LDB(B0, 0, 0); PG8_LDB(B1, 0, 1); PG8_SCHED; PG8_LDA(At, 0, 0); PG8_STAGE(PG8_SA(1, 1), a1 + hstep, voffA);
            PG8_WAIT_V(8); PG8_WAIT_L(0); PG8_BAR; PG8_MMA(0, 0, At, B0); PG8_MMA(0, 1, At, B1); PG8_BAR; PG8_SCHED;
            PG8_LDA(At, 0, 1); PG8_STAGE(PG8_SB(0, 0), b2, voffB); PG8_STAGE(PG8_SB(0, 1), b2 + hstep, voffB); PG8_STAGE(PG8_SA(0, 0), a2, voffA);
            PG8_WAIT_V(8); PG8_WAIT_L(0); PG8_BAR; PG8_MMA(1, 0, At, B0); PG8_MMA(1, 1, At, B1); PG8_BAR; PG8_SCHED;
            PG8_LDB(B0, 1, 0); PG8_LDB(B1, 1, 1); PG8_SCHED; PG8_LDA(At, 1, 0); PG8_STAGE(PG8_SA(0, 1), a2 + hstep, voffA);
            PG8_WAIT_V(8); PG8_WAIT_L(0); PG8_BAR; PG8_MMA(0, 0, At, B0); PG8_MMA(0, 1, At, B1); PG8_BAR; PG8_SCHED;
            PG8_LDA(At, 1, 1); PG8_STAGE(PG8_SB(1, 0), b3, voffB); PG8_STAGE(PG8_SB(1, 1), b3 + hstep, voffB); PG8_STAGE(PG8_SA(1, 0), a3, voffA);
            PG8_WAIT_V(8); PG8_WAIT_L(0); PG8_BAR; PG8_MMA(1, 0, At, B0); PG8_MMA(1, 1, At, B1); PG8_BAR; PG8_SCHED;
            } else {
            PG8_LDB(B0, 0, 0); PG8_SCHED; PG8_LDA(At, 0, 0); PG8_STAGE(PG8_SA(1, 1), a1 + hstep, voffA);
            PG8_WAIT_L(8); PG8_BAR; PG8_WAIT_L(0); PG8_MMA(0, 0, At, B0); PG8_BAR; PG8_SCHED;
            PG8_LDB(B1, 0, 1); PG8_STAGE(PG8_SB(0, 0), b2, voffB);
            PG8_BAR; PG8_WAIT_L(0); PG8_MMA(0, 1, At, B1); PG8_BAR;
            PG8_LDA(At, 0, 1); PG8_STAGE(PG8_SA(0, 0), a2, voffA);
            PG8_BAR; PG8_WAIT_L(0); PG8_MMA(1, 0, At, B0); PG8_BAR; PG8_SCHED;
            PG8_STAGE(PG8_SB(0, 1), b2 + hstep, voffB);
            PG8_WAIT_V(6); PG8_BAR; PG8_MMA(1, 1, At, B1); PG8_BAR;
            PG8_LDB(B0, 1, 0); PG8_SCHED; PG8_LDA(At, 1, 0); PG8_STAGE(PG8_SA(0, 1), a2 + hstep, voffA);
            PG8_WAIT_L(8); PG8_BAR; PG8_WAIT_L(0); PG8_MMA(0, 0, At, B0); PG8_BAR; PG8_SCHED;
            PG8_LDB(B1, 1, 1); PG8_STAGE(PG8_SB(1, 0), b3, voffB);
            PG8_BAR; PG8_WAIT_L(0); PG8_MMA(0, 1, At, B1); PG8_BAR;
            PG8_LDA(At, 1, 1); PG8_STAGE(PG8_SA(1, 0), a3, voffA);
            PG8_BAR; PG8_WAIT_L(0); PG8_MMA(1, 0, At, B0); PG8_BAR; PG8_SCHED;
            PG8_STAGE(PG8_SB(1, 1), b3 + hstep, voffB);
            PG8_WAIT_V(6); PG8_BAR; PG8_MMA(1, 1, At, B1); PG8_BAR;
            }
        }
        if constexpr (ALIGN_EPI) { if (wr == 0) PG8_BAR; }
        if constexpr (!Epi::AFTER_DRAIN) { E(acc, cur, wr, wc, fr, fq); S.done(cur); }
        if (!has_next) break;
#pragma unroll
        for (int a = 0; a < 2; ++a)
#pragma unroll
            for (int b = 0; b < 2; ++b)
#pragma unroll
                for (int m = 0; m < 4; ++m)
#pragma unroll
                    for (int n = 0; n < 2; ++n) acc[a][b][m][n] = (f32x4){0.f, 0.f, 0.f, 0.f};
        cur = nxt; cA = nA; cB = nB; ++ui;
        if constexpr (ALIGN_EPI) { if (wr == 1) PG8_BAR; }
    }
    PG8_WAIT_V(0);
    if constexpr (!ALIGN_EPI) { if (wr == 0) PG8_BAR; }
    PG8_BAR;
#undef PG8_SA
#undef PG8_SB
#undef PG8_STAGE
#undef PG8_LDA
#undef PG8_LDB
#undef PG8_MMA
#undef PG8_WAIT_V
#undef PG8_WAIT_L
#undef PG8_BAR
#undef PG8_SCHED
}
}

constexpr int NWAVES = 8, NTHREADS = NWAVES * 64;
constexpr int DM = 2048, DIN = 6656, DFF = 5632, DUP = 2 * DFF, DEPTH = 2;
constexpr int MG = 16384;
constexpr int RET_H = 8, NA_H = 12, DIFF_H = 6;
constexpr int C_RQ = 0, C_RK = 512, C_RV = 1024, C_RG = 1536, C_NQ = 2048, C_NK = 2816, C_NV = 3584, C_DQ = 4352, C_DK = 5120, C_DV = 5888;
constexpr int MIX_RET = 0, MIX_NA = 512, MIX_DIFF = 1280;
constexpr float NORM_EPS = 1e-6f;
constexpr float LOG2E = 1.4426950408889634f;

constexpr size_t MiB = 1u << 20;
constexpr size_t WS_CTL = 0, CTL_ZERO_BYTES = 2 * MiB;
constexpr int MT = 2 * MG;
constexpr size_t WS_WIN = 2 * MiB;
constexpr size_t WS_WUP = 54 * MiB;
constexpr size_t WS_H = 142 * MiB;
constexpr size_t WS_PROJ = 270 * MiB;
constexpr size_t WS_ACT = 686 * MiB;
constexpr size_t WS_END = 703 * MiB;
constexpr size_t OUT_MIX = 0;
constexpr size_t OUT_WOUT = 128 * MiB;
constexpr size_t OUT_WDN = 144 * MiB;
static_assert(OUT_WDN + 44 * MiB <= (size_t)MT * DM * 4 && WS_ACT + (size_t)3 * (MT / 256) * 2 * DFF * 4 <= WS_END && WS_PROJ + (size_t)MT * DIN * 2 <= WS_ACT, "workspace map");
constexpr int NBG = 32;
constexpr int CW_BAR = 4096;
constexpr int CW_QUEUE = 8192;
constexpr size_t WS_HBAR = 3 * MiB / 2;
constexpr size_t WS_SS = 65536;
static_assert(WS_SS + (size_t)2 * 5 * MG * 8 <= CTL_ZERO_BYTES && CTL_ZERO_BYTES <= WS_WIN && (CW_BAR + 3456) <= CW_QUEUE && (CW_QUEUE + 12 * 64) * 4 <= (int)WS_SS, "CTL map");

constexpr int RING_OFF = 0, RING_BYTES = 143360;
constexpr int LDSCTL_OFF = RING_BYTES, MISC_OFF = LDSCTL_OFF + 320;
constexpr int LDS_BYTES = 147456;

#define GAS __attribute__((address_space(1)))
#define LAS __attribute__((address_space(3)))
typedef unsigned short bf16;
typedef unsigned v4u __attribute__((ext_vector_type(4)));
typedef float f32x4 __attribute__((ext_vector_type(4)));
typedef GAS unsigned gu32;
#define RLX_AGENT __ATOMIC_RELAXED, __HIP_MEMORY_SCOPE_AGENT
#define LDS_WAIT() asm volatile("s_waitcnt lgkmcnt(0)" ::: "memory")
__device__ __forceinline__ unsigned f2bf(float f) { unsigned u = __builtin_bit_cast(unsigned, f); return (u + 0x7fffu + ((u >> 16) & 1u)) >> 16; }
__device__ __forceinline__ unsigned pk2(float lo, float hi) { return f2bf(lo) | (f2bf(hi) << 16); }
__device__ __forceinline__ float bflo(unsigned u) { return __uint_as_float(u << 16); }
__device__ __forceinline__ float bfhi(unsigned u) { return __uint_as_float(u & 0xffff0000u); }
__device__ __forceinline__ void unpack8(const v4u v, float* f) { f[0] = bflo(v.x); f[1] = bfhi(v.x); f[2] = bflo(v.y); f[3] = bfhi(v.y); f[4] = bflo(v.z); f[5] = bfhi(v.z); f[6] = bflo(v.w); f[7] = bfhi(v.w); }

#define XB_TMO      128
#define XB_XCNT(j)  (256  + 64 * (j))
#define XB_XSUB(j)  (1280 + 64 * (j))
#define XB_XGEN(j)  (2304 + 64 * (j))
#define XB_TOP      3328
#define XB_TOPGEN   3392
#define XCD_BAR_WORDS 3456
#define XB_SPIN_CAP (1u << 22)

__device__ __forceinline__ unsigned xb_ld(unsigned* p)              { return __hip_atomic_load(p, __ATOMIC_RELAXED, __HIP_MEMORY_SCOPE_AGENT); }
__device__ __forceinline__ unsigned xb_add(unsigned* p, unsigned v) { return __hip_atomic_fetch_add(p, v, __ATOMIC_RELAXED, __HIP_MEMORY_SCOPE_AGENT); }
__device__ __forceinline__ unsigned xb_xcc_id() { return (unsigned)__builtin_amdgcn_s_getreg((3 << 11) | 20) & 0xFu; }
#define XB_SPIN(cond, bar) do { unsigned _sp = 0; while (cond) { __builtin_amdgcn_s_sleep(1); \
    if ((++_sp & 255u) == 0u) { if (xb_ld(&(bar)[XB_TMO])) break; if (_sp > XB_SPIN_CAP) { __hip_atomic_store(&(bar)[XB_TMO], 1u, __ATOMIC_RELAXED, __HIP_MEMORY_SCOPE_AGENT); break; } } } } while (0)

struct XcdBarrier { unsigned* bar; unsigned x; volatile LAS unsigned* st; int wave; unsigned np; };

__device__ __forceinline__ XcdBarrier xcd_barrier_post(unsigned* bar, volatile LAS unsigned* st, int wave, unsigned np = 0u) {
    XcdBarrier b; b.bar = bar; b.x = xb_xcc_id(); b.st = st; b.wave = wave; b.np = np;
    if (threadIdx.x == 0) (void)xb_add(&bar[XB_XCNT(b.x)], 1u);
    return b;
}
__device__ __forceinline__ void xcd_barrier_complete(unsigned* bar, unsigned x, unsigned& nloc, unsigned& nx, unsigned np) {
    asm volatile("" : "+s"(x));
    const unsigned G = np ? np : gridDim.x * gridDim.y * gridDim.z;
    unsigned sum, cnt, mine, sp = 0u;
    for (;;) {
        sum = 0u; cnt = 0u; mine = 0u;
#pragma unroll
        for (unsigned j = 0; j < 16; ++j) { const unsigned c = xb_ld(&bar[XB_XCNT(j)]); sum += c; cnt += (c > 0u) ? 1u : 0u; mine = (j == x) ? c : mine; }
        if (sum == G) break;
        __builtin_amdgcn_s_sleep(1);
        if ((++sp & 255u) == 0u) { if (xb_ld(&bar[XB_TMO])) break; if (sp > XB_SPIN_CAP) { __hip_atomic_store(&bar[XB_TMO], 1u, __ATOMIC_RELAXED, __HIP_MEMORY_SCOPE_AGENT); break; } }
    }
    nloc = mine > 0u ? mine : 1u; nx = cnt > 0u ? cnt : 1u;
}
__device__ __forceinline__ void xcd_barrier(const XcdBarrier& b) {
    asm volatile("s_waitcnt vmcnt(0)" ::: "memory");
    __syncthreads();
    if (b.wave == 0 && lane_id_now() == 0) {
        unsigned* bar = b.bar; asm volatile("" : "+s"(bar));
        __builtin_amdgcn_s_waitcnt(0);
        unsigned nloc = b.st[0], nx = b.st[1];
        if (nloc == 0u) { xcd_barrier_complete(bar, b.x, nloc, nx, b.np); b.st[0] = nloc; b.st[1] = nx; }
        const unsigned old = xb_add(&bar[XB_XSUB(b.x)], 1u);
        const unsigned gen = old / nloc;
        if (old + 1u == (gen + 1u) * nloc) {
            __builtin_amdgcn_fence(__ATOMIC_RELEASE, "agent");
            asm volatile("s_waitcnt vmcnt(0)" ::: "memory");
            const unsigned og = xb_add(&bar[XB_TOP], 1u);
            const unsigned tg = og / nx;
            if (og + 1u == (tg + 1u) * nx) xb_add(&bar[XB_TOPGEN], 1u);
            else XB_SPIN(xb_ld(&bar[XB_TOPGEN]) == tg, bar);
            __builtin_amdgcn_fence(__ATOMIC_ACQUIRE, "agent");
            xb_add(&bar[XB_XGEN(b.x)], 1u);
            asm volatile("s_waitcnt vmcnt(0)" ::: "memory");
        } else {
            XB_SPIN(xb_ld(&bar[XB_XGEN(b.x)]) == gen, bar);
            __builtin_amdgcn_fence(__ATOMIC_ACQUIRE, "agent");
            asm volatile("s_waitcnt vmcnt(0)" ::: "memory");
        }
    }
    __syncthreads();
}

struct Frame {
    LAS unsigned char* lds;
    int tid, lane, wave;
    int G, bx;
};
__device__ __forceinline__ void frame_refresh(Frame& F) { int ln = lane_id_now();
    F.lane = ln; F.tid = F.wave * 64 + ln; }
template <int O> __device__ __forceinline__ float swz_xor(float v) { return __int_as_float(__builtin_amdgcn_ds_swizzle(__float_as_int(v), (O << 10) | 0x1f)); }
__device__ __forceinline__ void mul_inplace(float& x, float a) { asm volatile("v_mul_f32 %0, %0, %1" : "+v"(x) : "v"(a)); }
__device__ __forceinline__ int q_next(unsigned* ctr, volatile LAS int* slot, int wave, int lane) {
    __syncthreads();
    if (wave == 0 && lane == 0) *slot = (int)__hip_atomic_fetch_add(ctr, 1u, __ATOMIC_RELAXED, __HIP_MEMORY_SCOPE_AGENT);
    __syncthreads();
    return *slot;
}
__device__ __forceinline__ void store_pair16(bf16* rowp_k, int hh, unsigned ax, unsigned ay, unsigned bx, unsigned by) {
    auto r0 = __builtin_amdgcn_permlane32_swap(ax, bx, false, false); auto r1 = __builtin_amdgcn_permlane32_swap(ay, by, false, false);
    v4u w; w.x = r0[0]; w.y = r1[0]; w.z = r0[1]; w.w = r1[1];
    *(v4u*)(rowp_k + 8 * hh) = w;
}
__device__ __forceinline__ float wave_sum(float v) {
    v += swz_xor<1>(v); v += swz_xor<2>(v); v += swz_xor<4>(v); v += swz_xor<8>(v); v += swz_xor<16>(v);
    auto rr = __builtin_amdgcn_permlane32_swap(__float_as_uint(v), __float_as_uint(v), false, false);
    return __uint_as_float(rr[0]) + __uint_as_float(rr[1]);
}

template <bool UPMAP> __device__ __forceinline__ void p0_transpose_item(const float* W, int K, int N, bf16* WT, const float* gain, LAS float* scr, int item, int lane) {
    const int nblk = N / 64, kb = item / nblk, nb = item % nblk, k0 = 64 * kb, n0 = 64 * nb;
    const int lr = lane >> 4, lc = (lane & 15) * 4;
    f32x4 v[16]; float gsc[16];
#pragma unroll
    for (int i = 0; i < 16; ++i) { const int kk = 4 * i + lr; gsc[i] = gain ? gain[k0 + kk] : 1.f; v[i] = *(const GAS f32x4*)(W + (size_t)(k0 + kk) * N + n0 + lc); }
#pragma unroll
    for (int i = 0; i < 16; ++i) { const int kk = 4 * i + lr; LAS float* d = scr + kk * 65 + lc; d[0] = v[i].x * gsc[i]; d[1] = v[i].y * gsc[i]; d[2] = v[i].z * gsc[i]; d[3] = v[i].w * gsc[i]; }
    LDS_WAIT(); asm volatile("" ::: "memory");
    const int c = lane & 7;
    int r0 = n0;
    if (UPMAP) { const int isg = n0 >= DFF ? 1 : 0, chn = n0 - isg * DFF; r0 = 256 * (chn / 128) + 128 * isg + (chn % 128); }
#pragma unroll
    for (int j = 0; j < 8; ++j) { const int n = (lane >> 3) + 8 * j; const LAS float* sp = scr + (8 * c) * 65 + n;
        v4u o; o.x = pk2(sp[0 * 65], sp[1 * 65]); o.y = pk2(sp[2 * 65], sp[3 * 65]); o.z = pk2(sp[4 * 65], sp[5 * 65]); o.w = pk2(sp[6 * 65], sp[7 * 65]);
        *(GAS v4u*)(WT + (size_t)(r0 + n) * K + k0 + 8 * c) = o; }
    LDS_WAIT(); asm volatile("" ::: "memory");
}
template <bool UPMAP> __device__ __forceinline__ void transpose_matrix(Frame& F, const float* W, int K, int N, bf16* WT, const float* gain, int bx0 = 0, int nb = 0) {
    LAS float* scr = (LAS float*)(F.lds + RING_OFF + F.wave * 16640);
    const int gw = (F.bx - bx0) * NWAVES + F.wave, NGW = (nb ? nb : F.G) * NWAVES;
    const int nitems = (K / 64) * (N / 64);
    for (int it = gw; it < nitems; it += NGW) p0_transpose_item<UPMAP>(W, K, N, WT, gain, scr, it, F.lane);
}

typedef unsigned long long ssq_t;
__device__ __forceinline__ ssq_t ss_pack(float v) { const float hi = floorf(v); return ((ssq_t)(unsigned)hi << 24) + (ssq_t)(unsigned)((v - hi) * 16777216.f); }
__device__ __forceinline__ float ss_unpack(ssq_t q) { return __builtin_fmaf((float)(unsigned)(q >> 32), 256.f, (float)(unsigned)(q & 0xffffffffull) * (1.f / 16777216.f)); }
__device__ __forceinline__ void convert_rows(Frame& F, const float* xin, bf16* xb, ssq_t* ss, int nrows) {
    frame_refresh(F);
    const int gw = F.bx * NWAVES + F.wave, NGW = F.G * NWAVES;
    for (int m = gw; m < nrows; m += NGW) {
        const GAS f32x4* xr = (const GAS f32x4*)(xin + (size_t)m * DM) + F.lane;
        f32x4 v[8]; float sq = 0.f;
#pragma unroll
        for (int j = 0; j < 8; ++j) { v[j] = xr[64 * j]; sq += (v[j].x * v[j].x + v[j].y * v[j].y) + (v[j].z * v[j].z + v[j].w * v[j].w); }
        sq = wave_sum(sq);
        GAS unsigned long long* o8 = (GAS unsigned long long*)(xb + (size_t)m * DM) + F.lane;
#pragma unroll
        for (int j = 0; j < 8; ++j) o8[64 * j] = (unsigned long long)pk2(v[j].x, v[j].y) | ((unsigned long long)pk2(v[j].z, v[j].w) << 32);
        if (F.lane == 0) ss[m] = ss_pack(sq);
    }
}
__device__ __forceinline__ void final_norm_rows(Frame& F, const bf16* xb, const ssq_t* ss, const float* w, float* out, int nrows, int bx0 = 0, int nb = 0) {
    frame_refresh(F);
    const int gw = (F.bx - bx0) * NWAVES + F.wave, NGW = (nb ? nb : F.G) * NWAVES;
    for (int m = gw; m < nrows; m += NGW) {
        const float rstd = 1.f / sqrtf(ss_unpack(ss[m]) * (1.f / DM) + NORM_EPS);
#pragma unroll
        for (int j = 0; j < 4; ++j) { const int c0 = (64 * j + F.lane) * 8; float f[8]; unpack8(*(const GAS v4u*)(xb + (size_t)m * DM + c0), f);
            const f32x4 g0 = *(const GAS f32x4*)(w + c0), g1 = *(const GAS f32x4*)(w + c0 + 4);
            GAS f32x4* o = (GAS f32x4*)(out + (size_t)m * DM + c0);
            o[0] = (f32x4){f[0] * rstd * g0.x, f[1] * rstd * g0.y, f[2] * rstd * g0.z, f[3] * rstd * g0.w};
            o[1] = (f32x4){f[4] * rstd * g1.x, f[5] * rstd * g1.y, f[6] * rstd * g1.z, f[7] * rstd * g1.w}; }
    }
}

struct EpiBf16Scale {
    static constexpr bool PERM = true, AFTER_DRAIN = false;
    bf16* O; int ldc; const ssq_t* ss;
    __device__ __forceinline__ void operator()(const pg8::f32x4 (&acc)[2][2][4][2], const pg8::Unit& u, int wr, int wc, int fr, int fq) const {
        const int row0 = u.pm * 256 + wr * 64 + fr; const int col0 = u.pn * 256 + wc * 32 + 8 * fq;
#pragma unroll
        for (int ai = 0; ai < 2; ++ai)
#pragma unroll
            for (int m = 0; m < 4; ++m) { const int row = row0 + ai * 128 + m * 16; bf16* rowp = O + (size_t)row * ldc + col0;
                const float rstd = __builtin_amdgcn_rsqf(ss_unpack(ss[row]) * (1.f / DM) + NORM_EPS);
#pragma unroll
                for (int bj = 0; bj < 2; ++bj) { const pg8::f32x4 v0 = acc[ai][bj][m][0] * rstd, v1 = acc[ai][bj][m][1] * rstd;
                    v4u w; w.x = pg8::cvt_pk_bf16(v0[0], v0[1]); w.y = pg8::cvt_pk_bf16(v0[2], v0[3]); w.z = pg8::cvt_pk_bf16(v1[0], v1[1]); w.w = pg8::cvt_pk_bf16(v1[2], v1[3]);
                    *(v4u*)(rowp + bj * 128) = w; } }
    }
};
struct EpiResNorm {
    static constexpr bool PERM = true, AFTER_DRAIN = false;
    const bf16* Xin; bf16* XB; ssq_t* ss; int ldc;
    __device__ __forceinline__ void operator()(const pg8::f32x4 (&acc)[2][2][4][2], const pg8::Unit& u, int wr, int wc, int fr, int fq) const {
        const int row0 = u.pm * 256 + wr * 64 + fr; const int col0 = u.pn * 256 + wc * 32 + 8 * fq;
#pragma unroll
        for (int ai = 0; ai < 2; ++ai)
#pragma unroll
            for (int m = 0; m < 4; ++m) { const int row = row0 + ai * 128 + m * 16; const size_t off = (size_t)row * ldc + col0; float sq = 0.f;
#pragma unroll
                for (int bj = 0; bj < 2; ++bj) { pg8::f32x4 x0, x1;
                    { float f[8]; unpack8(*(const v4u*)(Xin + off + bj * 128), f); x0 = (pg8::f32x4){f[0], f[1], f[2], f[3]}; x1 = (pg8::f32x4){f[4], f[5], f[6], f[7]}; }
                    const pg8::f32x4 v0 = x0 + acc[ai][bj][m][0], v1 = x1 + acc[ai][bj][m][1];
                    v4u w; w.x = pg8::cvt_pk_bf16(v0[0], v0[1]); w.y = pg8::cvt_pk_bf16(v0[2], v0[3]); w.z = pg8::cvt_pk_bf16(v1[0], v1[1]); w.w = pg8::cvt_pk_bf16(v1[2], v1[3]);
                    *(v4u*)(XB + off + bj * 128) = w;
                    sq += (v0[0] * v0[0] + v0[1] * v0[1]) + (v0[2] * v0[2] + v0[3] * v0[3]) + (v1[0] * v1[0] + v1[1] * v1[1]) + (v1[2] * v1[2] + v1[3] * v1[3]); }
                sq += swz_xor<16>(sq); { auto rr = __builtin_amdgcn_permlane32_swap(__float_as_uint(sq), __float_as_uint(sq), false, false); sq = __uint_as_float(rr[0]) + __uint_as_float(rr[1]); }
                if (fq == 0) atomicAdd(ss + row, ss_pack(sq));
                if (m & 1) asm volatile("" ::: "memory"); }
    }
};

__device__ __forceinline__ float dpp_ror1(float v)  { return __int_as_float(__builtin_amdgcn_update_dpp(0, __float_as_int(v), 0x121, 0xf, 0xf, true)); }
__device__ __forceinline__ float dpp_ror15(float v) { return __int_as_float(__builtin_amdgcn_update_dpp(0, __float_as_int(v), 0x12f, 0xf, 0xf, true)); }
__device__ __forceinline__ float dpp_shr1(float old, float v) { return __int_as_float(__builtin_amdgcn_update_dpp(__float_as_int(old), __float_as_int(v), 0x111, 0xf, 0xf, false)); }
__device__ __forceinline__ float dpp_shl1(float old, float v) { return __int_as_float(__builtin_amdgcn_update_dpp(__float_as_int(old), __float_as_int(v), 0x101, 0xf, 0xf, false)); }
__device__ __forceinline__ float gelu_tanh_fast(float x) { const float arg = x * fmaf(x * x, -0.102943239f, -2.302208198f); return x * __builtin_amdgcn_rcpf(1.f + __builtin_amdgcn_exp2f(arg)); }
constexpr int HALO_OFF = 131072;
struct EpiUpConv {
    static constexpr bool PERM = true, AFTER_DRAIN = false;
    bf16* ACT; const ssq_t* ss; const float* cw; const float* cb; float* EP; float* EA; float* EG; LAS unsigned char* lds;
    __device__ __forceinline__ void operator()(pg8::f32x4 (&acc)[2][2][4][2], const pg8::Unit& u, int wr, int wc, int fr, int fq) const {
        const int row0 = u.pm * 256 + wr * 64 + fr; const int ch0 = u.pn * 128 + wc * 32 + 8 * fq;
        LAS float* H = (LAS float*)(lds + HALO_OFF);
#pragma unroll
        for (int ai = 0; ai < 2; ++ai)
#pragma unroll
            for (int m = 0; m < 4; ++m) { const float rstd = __builtin_amdgcn_rsqf(ss_unpack(ss[row0 + ai * 128 + m * 16]) * (1.f / DM) + NORM_EPS);
#pragma unroll
                for (int bj = 0; bj < 2; ++bj)
#pragma unroll
                    for (int n = 0; n < 2; ++n) acc[ai][bj][m][n] *= rstd; }
#pragma unroll
        for (int ai = 0; ai < 2; ++ai) { const int sl = 2 * ai + wr; LAS float* hp = H + (sl * 2) * 128 + wc * 32 + 8 * fq;
            if (fr == 0) { *(LAS pg8::f32x4*)(hp) = acc[ai][1][0][0]; *(LAS pg8::f32x4*)(hp + 4) = acc[ai][1][0][1]; }
            if (fr == 15) { *(LAS pg8::f32x4*)(hp + 128) = acc[ai][1][3][0]; *(LAS pg8::f32x4*)(hp + 128 + 4) = acc[ai][1][3][1]; } }
        asm volatile("s_waitcnt lgkmcnt(0)" ::: "memory"); __builtin_amdgcn_s_barrier(); asm volatile("" ::: "memory");
        const pg8::f32x4 zero4 = (pg8::f32x4){0.f, 0.f, 0.f, 0.f};
        pg8::f32x4 w0[2], w1[2], w2[2], bb[2];
#pragma unroll
        for (int n = 0; n < 2; ++n) { w0[n] = *(const pg8::f32x4*)(cw + ch0 + 4 * n); w1[n] = *(const pg8::f32x4*)(cw + DFF + ch0 + 4 * n); w2[n] = *(const pg8::f32x4*)(cw + 2 * DFF + ch0 + 4 * n); bb[n] = *(const pg8::f32x4*)(cb + ch0 + 4 * n); }
#pragma unroll
        for (int ai = 0; ai < 2; ++ai) { const int sl = 2 * ai + wr;
            pg8::f32x4 hu[2], hd[2];
#pragma unroll
            for (int n = 0; n < 2; ++n) { hu[n] = sl > 0 ? *(const LAS pg8::f32x4*)(H + ((sl - 1) * 2 + 1) * 128 + wc * 32 + 8 * fq + 4 * n) : zero4;
                                          hd[n] = sl < 3 ? *(const LAS pg8::f32x4*)(H + ((sl + 1) * 2) * 128 + wc * 32 + 8 * fq + 4 * n) : zero4; }
#pragma unroll
            for (int m = 0; m < 4; ++m) { const int row = row0 + ai * 128 + m * 16; float o[8]; float gcv[8];
#pragma unroll
                for (int n = 0; n < 2; ++n)
#pragma unroll
                    for (int e = 0; e < 4; ++e) { const float gv = acc[ai][1][m][n][e];
                        const float xu = (fr == 15) ? (m > 0 ? acc[ai][1][m > 0 ? m - 1 : 0][n][e] : hu[n][e]) : gv;
                        const float xd = (fr == 0) ? (m < 3 ? acc[ai][1][m < 3 ? m + 1 : 3][n][e] : hd[n][e]) : gv;
                        float gc = fmaf(w1[n][e], gv, bb[n][e]);
                        gc = fmaf(dpp_ror1(xu), w0[n][e], gc);
                        gc = fmaf(dpp_ror15(xd), w2[n][e], gc);
                        gcv[4 * n + e] = gc; }
#pragma unroll
                for (int k2 = 0; k2 < 4; ++k2) { typedef float f32x2v __attribute__((ext_vector_type(2)));
                    const f32x2v x = (f32x2v){gcv[2 * k2], gcv[2 * k2 + 1]}, av = (f32x2v){acc[ai][0][m][k2 >> 1][2 * (k2 & 1)], acc[ai][0][m][k2 >> 1][2 * (k2 & 1) + 1]};
                    const f32x2v arg = x * (x * x * (f32x2v){-0.102943239f, -0.102943239f} + (f32x2v){-2.302208198f, -2.302208198f});
                    const f32x2v dn = (f32x2v){__builtin_amdgcn_exp2f(arg.x), __builtin_amdgcn_exp2f(arg.y)} + (f32x2v){1.f, 1.f};
                    const f32x2v r = (x * av) * (f32x2v){__builtin_amdgcn_rcpf(dn.x), __builtin_amdgcn_rcpf(dn.y)};
                    o[2 * k2] = r.x; o[2 * k2 + 1] = r.y; }
                const bool etop = (sl == 0 && m == 0 && fr == 0), ebot = (sl == 3 && m == 3 && fr == 15);
                if (etop || ebot) { const size_t eo = ((size_t)u.pm * 2 + (ebot ? 1 : 0)) * DFF + ch0;
#pragma unroll
                    for (int n = 0; n < 2; ++n) { *(pg8::f32x4*)(EP + eo + 4 * n) = (pg8::f32x4){gcv[4 * n], gcv[4 * n + 1], gcv[4 * n + 2], gcv[4 * n + 3]};
                        *(pg8::f32x4*)(EA + eo + 4 * n) = acc[ai][0][m][n]; *(pg8::f32x4*)(EG + eo + 4 * n) = acc[ai][1][m][n]; }
                } else { v4u w; w.x = pg8::cvt_pk_bf16(o[0], o[1]); w.y = pg8::cvt_pk_bf16(o[2], o[3]); w.z = pg8::cvt_pk_bf16(o[4], o[5]); w.w = pg8::cvt_pk_bf16(o[6], o[7]);
                    *(v4u*)(ACT + (size_t)row * DFF + ch0) = w; }
            }
        }
    }
};
__device__ __forceinline__ void ffn_edge_fixup_panel(Frame& F, bf16* ACT, const float* EP, const float* EA, const float* EG, const float* cw, int S, int pm) {
    constexpr int NC4 = DFF / 4;
    for (int it = F.tid; it < 2 * NC4; it += NTHREADS) {
        const int c4 = (it % NC4) * 4, tbq = it / NC4;
        const int row = pm * 256 + (tbq ? 255 : 0);
        const size_t eo = ((size_t)pm * 2 + tbq) * DFF + c4;
        f32x4 gp = *(const f32x4*)(EP + eo); const f32x4 av = *(const f32x4*)(EA + eo);
        if (tbq == 0) { if (row % S != 0) { const f32x4 gn = *(const f32x4*)(EG + ((size_t)(pm - 1) * 2 + 1) * DFF + c4), w = *(const f32x4*)(cw + c4); gp = gp + gn * w; } }
        else { if ((row + 1) % S != 0) { const f32x4 gn = *(const f32x4*)(EG + ((size_t)(pm + 1) * 2) * DFF + c4), w = *(const f32x4*)(cw + 2 * DFF + c4); gp = gp + gn * w; } }
        const unsigned lo = pg8::cvt_pk_bf16(gelu_tanh_fast(gp.x) * av.x, gelu_tanh_fast(gp.y) * av.y), hi = pg8::cvt_pk_bf16(gelu_tanh_fast(gp.z) * av.z, gelu_tanh_fast(gp.w) * av.w);
        *(unsigned long long*)(ACT + (size_t)row * DFF + c4) = (unsigned long long)lo | ((unsigned long long)hi << 32);
    }
}
typedef short bf16x8 __attribute__((ext_vector_type(8)));
typedef float f32x16 __attribute__((ext_vector_type(16)));
typedef short s16x4 __attribute__((ext_vector_type(4)));
typedef short v4i16_t __attribute__((ext_vector_type(4)));
__device__ __forceinline__ unsigned cvtpk(float lo, float hi) { unsigned r; asm("v_cvt_pk_bf16_f32 %0, %1, %2" : "=v"(r) : "v"(lo), "v"(hi)); return r; }
__device__ __forceinline__ float half_max(float v) { auto rr = __builtin_amdgcn_permlane32_swap(__float_as_uint(v), __float_as_uint(v), false, false); return fmaxf(__uint_as_float(rr[0]), __uint_as_float(rr[1])); }
__device__ __forceinline__ float half_sum(float v) { auto rr = __builtin_amdgcn_permlane32_swap(__float_as_uint(v), __float_as_uint(v), false, false); return __uint_as_float(rr[0]) + __uint_as_float(rr[1]); }
#define TR_READ(dst, addr, imm) asm volatile("ds_read_b64_tr_b16 %0, %1 offset:%c2" : "=&v"(dst) : "v"(addr), "i"(imm) : "memory")
#define LGKM_WAIT(n) asm volatile("s_waitcnt lgkmcnt(" #n ")" ::: "memory")
#define VFRAG(lo, hi) ((bf16x8){(lo)[0], (lo)[1], (lo)[2], (lo)[3], (hi)[0], (hi)[1], (hi)[2], (hi)[3]})

constexpr int DF_KMAP = 8192, DF_V = 16384, DF_BUF = 32768;
constexpr int DF_Q = 2 * DF_BUF, DF_QROW = 272;
static_assert(DF_Q + 8 * 32 * DF_QROW <= RING_BYTES, "diff attention LDS");
__device__ __forceinline__ void diff_mfma(Frame& F, const bf16* proj, bf16* mix, const float* nw, float lam, float lam_init, int S, int nseq, unsigned* qctr) {
    frame_refresh(F);
    const int lane = F.lane, wave = F.wave, q32 = lane & 31, hh = lane >> 5;
    LAS unsigned char* L = F.lds + RING_OFF;
    const int nqb = S / 256, nunits = nseq * DIFF_H * nqb, NT = S / 64;
    const unsigned kaddr0 = (unsigned)(q32 * 128 + (((((q32 >> 1) & 7) >> 1) << 1 | (hh ^ ((q32 >> 1) & 1))) * 16));
    const int i16 = lane & 15, q4 = i16 >> 2, p4 = i16 & 3, g1 = (lane >> 4) & 1;
    const unsigned trlo = (unsigned)(DF_V + 64 * (4 * hh + q4) + 16 * ((2 * g1 + (p4 >> 1)) ^ hh) + 8 * (p4 & 1));
    const unsigned trhi = (unsigned)(DF_V + 2048 + 64 * (4 * hh + q4) + 16 * ((2 * g1 + (p4 >> 1)) ^ ((2 + hh) & 3)) + 8 * (p4 & 1));
    const float sc2 = 0.125f * LOG2E;
#define DF_STAGE(buf, tile) do { const bf16* k0_ = kg + (size_t)(tile) * 64 * DIN; const bf16* k1_ = k0_ + 64; const bf16* v0_ = vg + (size_t)(tile) * 64 * DIN; const bf16* v1_ = v0_ + 32 * DIN; \
        unsigned ko_ = kgoffB, vo_ = vgoffB; asm volatile("" : "+s"(k0_), "+s"(k1_), "+s"(v0_), "+s"(v1_), "+v"(ko_), "+v"(vo_)); \
        LAS unsigned char* Bw_ = L + (buf) * DF_BUF + wave * 1024; \
        __builtin_amdgcn_global_load_lds((const unsigned*)((const char*)k0_ + ko_), (LAS unsigned*)(Bw_), 16, 0, 0); \
        __builtin_amdgcn_global_load_lds((const unsigned*)((const char*)k1_ + ko_), (LAS unsigned*)(Bw_ + DF_KMAP), 16, 0, 0); \
        __builtin_amdgcn_global_load_lds((const unsigned*)((const char*)v0_ + vo_), (LAS unsigned*)(Bw_ + DF_V), 16, 0, 0); \
        __builtin_amdgcn_global_load_lds((const unsigned*)((const char*)v1_ + vo_), (LAS unsigned*)(Bw_ + DF_V + 8192), 16, 0, 0); } while (0)
    for (;;) {
        const int lane_u = lane_id_now();
        const int it = q_next(qctr, (volatile LAS int*)(F.lds + MISC_OFF + 64), wave, lane_u); if (it >= nunits) break;
        const int qb = it % nqb, h = (it / nqb) % DIFF_H, s = it / (nqb * DIFF_H);
        const int row0 = s * S;
        const float nslope2 = __uint_as_float(__builtin_amdgcn_readfirstlane(__float_as_uint(-exp2f(-8.f * (float)(h + 1) / 6.f) * LOG2E)));
        const int ih = qb * 256 + wave * 32 + (lane_u & 31) - 4 * (lane_u >> 5);
        const int td = (qb * 256 + wave * 32) >> 6;
        const int kkey = 8 * wave + (lane_u >> 3);
        const unsigned kgoffB = (unsigned)(kkey * DIN + ((lane_u & 7) ^ ((kkey >> 1) & 7)) * 8) * 2u;
        unsigned vgoffB;
        { const int pv = wave, rowhi = pv >> 1, chhi = 2 * (pv & 1) + (lane_u >> 5), r7 = (lane_u & 31) >> 2, slot = lane_u & 3;
          const int x = (2 * (rowhi & 1) + (r7 >> 2)) & 3, ch = 4 * chhi + (slot ^ x), row = 8 * rowhi + r7; vgoffB = (unsigned)(row * DIN + ch * 8) * 2u; }
        const bf16* kg = proj + (size_t)row0 * DIN + C_DK + h * 128;
        const bf16* vg = proj + (size_t)row0 * DIN + C_DV + h * 128;
        DF_STAGE(0, 0);
        bf16x8 qf[2][4];
        { const bf16* qp = proj + (size_t)(row0 + qb * 256 + wave * 32 + (lane_u & 31)) * DIN + C_DQ + h * 128 + (lane_u >> 5) * 8;
#pragma unroll
          for (int c = 0; c < 2; ++c)
#pragma unroll
              for (int ds = 0; ds < 4; ++ds) { float f[8]; unpack8(*(const v4u*)(qp + c * 64 + ds * 16), f);
                  v4u w; w.x = cvtpk(f[0] * sc2, f[1] * sc2); w.y = cvtpk(f[2] * sc2, f[3] * sc2); w.z = cvtpk(f[4] * sc2, f[5] * sc2); w.w = cvtpk(f[6] * sc2, f[7] * sc2);
                  qf[c][ds] = __builtin_bit_cast(bf16x8, w); } }
        const unsigned tra_lo = (unsigned)(uintptr_t)L + trlo, tra_hi = (unsigned)(uintptr_t)L + trhi;
        f32x16 O[2][4];
#pragma unroll
        for (int c = 0; c < 2; ++c)
#pragma unroll
            for (int db = 0; db < 4; ++db)
#pragma unroll
                for (int r = 0; r < 16; ++r) O[c][db][r] = 0.f;
        float m = 0.f, l[2] = {0.f, 0.f};
        asm volatile("s_waitcnt vmcnt(0)" ::: "memory");
        __syncthreads();
#pragma unroll 1
        for (int t2 = 0; t2 < NT; t2 += 2) {
#pragma unroll
          for (int tb_ = 0; tb_ < 2; ++tb_) {
            const int t = t2 + tb_;
            const LAS unsigned char* B = L + tb_ * DF_BUF;
            if (t + 1 < NT) DF_STAGE(tb_ ^ 1, t + 1);
            const float nsS = __uint_as_float(__builtin_amdgcn_readfirstlane(__float_as_uint(t < td ? nslope2 : -nslope2)));
            const float ns8 = __uint_as_float(__builtin_amdgcn_readfirstlane(__float_as_uint(8.f * nsS)));
#pragma unroll
            for (int kb = 0; kb < 2; ++kb) {
                bf16x8 kf[2][4];
#pragma unroll
                for (int c = 0; c < 2; ++c)
#pragma unroll
                    for (int ds = 0; ds < 4; ++ds) kf[c][ds] = *(const LAS bf16x8*)(B + c * DF_KMAP + kb * 4096 + (kaddr0 ^ (unsigned)(ds << 5)));
                __builtin_amdgcn_sched_barrier(0);
                f32x16 bias;
                float tbk = (float)(ih - t * 64 - 32 * kb); asm volatile("" : "+v"(tbk));
                if (__builtin_expect(t != td, 1)) {
                    const float b0 = __builtin_fmaf(tbk, nsS, -m);
                    bias[0] = b0; bias[4] = b0 - ns8; bias[8] = __builtin_fmaf(-2.f, ns8, b0); bias[12] = bias[8] - ns8;
#pragma unroll
                    for (int j = 0; j < 4; ++j) { bias[4 * j + 1] = bias[4 * j] - nsS; bias[4 * j + 2] = __builtin_fmaf(-2.f, nsS, bias[4 * j]); bias[4 * j + 3] = __builtin_fmaf(-2.f, nsS, bias[4 * j + 1]); }
                } else {
#pragma unroll
                    for (int r = 0; r < 16; ++r) bias[r] = __builtin_fmaf(__builtin_fabsf(tbk - (float)((r & 3) + 8 * (r >> 2))), nslope2, -m);
                }
                __builtin_amdgcn_sched_barrier(0);
                f32x16 a[2];
#pragma unroll
                for (int c = 0; c < 2; ++c)
#pragma unroll
                    for (int ds = 0; ds < 4; ++ds) a[c] = __builtin_amdgcn_mfma_f32_32x32x16_bf16(kf[c][ds], qf[c][ds], ds == 0 ? bias : a[c], 0, 0, 0);
                s16x4 vl[4][2], vh[4][2];
#define DF_VREQ(db) do { _Pragma("unroll") for (int sI = 0; sI < 2; ++sI) { TR_READ(vl[db][sI], tra_lo, tb_ * DF_BUF + 4096 * (2 * kb + sI) + 512 * (db)); TR_READ(vh[db][sI], tra_hi, tb_ * DF_BUF + 4096 * (2 * kb + sI) + 512 * (db)); } } while (0)
#define DF_PV(db) do { _Pragma("unroll") for (int sI = 0; sI < 2; ++sI) { const bf16x8 vf = VFRAG(vl[db][sI], vh[db][sI]); \
                        O[0][db] = __builtin_amdgcn_mfma_f32_32x32x16_bf16(vf, pf[0][sI], O[0][db], 0, 0, 0); O[1][db] = __builtin_amdgcn_mfma_f32_32x32x16_bf16(vf, pf[1][sI], O[1][db], 0, 0, 0); } } while (0)
                __builtin_amdgcn_sched_barrier(0);
                DF_VREQ(0); DF_VREQ(1);
                bf16x8 pf[2][2];
                float ls[2] = {0.f, 0.f};
#pragma unroll
                for (int c = 0; c < 2; ++c)
#pragma unroll
                    for (int r = 0; r < 16; ++r) { const float p = __builtin_amdgcn_exp2f(a[c][r]); ls[c] += p; a[c][r] = p; }
                if (__builtin_expect(__any(fmaxf(ls[0], ls[1]) > 65536.f), 0)) {
                    const float lm = fmaxf(ls[0], ls[1]);
                    const int e_ = __builtin_amdgcn_frexp_expf(lm) - 1; const float dl = half_max((float)(e_ > 0 ? e_ : 0)), alpha = __builtin_amdgcn_exp2f(-dl);
                    m += dl;
#pragma unroll
                    for (int c = 0; c < 2; ++c) { l[c] *= alpha; ls[c] *= alpha;
#pragma unroll
                        for (int r = 0; r < 16; ++r) { float x_ = a[c][r]; mul_inplace(x_, alpha); a[c][r] = x_; }
#pragma unroll
                        for (int db = 0; db < 4; ++db)
#pragma unroll
                            for (int r = 0; r < 16; ++r) { float x_ = O[c][db][r]; mul_inplace(x_, alpha); O[c][db][r] = x_; } } }
#pragma unroll
                for (int c = 0; c < 2; ++c) { l[c] += ls[c];
#pragma unroll
                    for (int sI = 0; sI < 2; ++sI) { v4u w; w.x = cvtpk(a[c][8 * sI], a[c][8 * sI + 1]); w.y = cvtpk(a[c][8 * sI + 2], a[c][8 * sI + 3]); w.z = cvtpk(a[c][8 * sI + 4], a[c][8 * sI + 5]); w.w = cvtpk(a[c][8 * sI + 6], a[c][8 * sI + 7]);
                        pf[c][sI] = __builtin_bit_cast(bf16x8, w); }
                }
                __builtin_amdgcn_sched_barrier(0);
                LGKM_WAIT(4); __builtin_amdgcn_sched_barrier(0);
                DF_VREQ(2); __builtin_amdgcn_sched_barrier(0);
                DF_PV(0);   __builtin_amdgcn_sched_barrier(0);
                LGKM_WAIT(4); __builtin_amdgcn_sched_barrier(0);
                DF_VREQ(3); __builtin_amdgcn_sched_barrier(0);
                DF_PV(1);   __builtin_amdgcn_sched_barrier(0);
                LGKM_WAIT(4); __builtin_amdgcn_sched_barrier(0);
                DF_PV(2);   __builtin_amdgcn_sched_barrier(0);
                LGKM_WAIT(0); __builtin_amdgcn_sched_barrier(0);
                DF_PV(3);   __builtin_amdgcn_sched_barrier(0);
#undef DF_VREQ
#undef DF_PV
            }
            asm volatile("s_waitcnt vmcnt(0) lgkmcnt(0)" ::: "memory");
            __builtin_amdgcn_s_barrier(); asm volatile("" ::: "memory");
          }
        }
        const float inv0 = 1.f / half_sum(l[0]), inv1 = lam / half_sum(l[1]);
        float ss = 0.f;
#pragma unroll
        for (int db = 0; db < 4; ++db)
#pragma unroll
            for (int r = 0; r < 16; ++r) { const float o = O[0][db][r] * inv0 - O[1][db][r] * inv1; O[0][db][r] = o; ss += o * o; }
        ss = half_sum(ss);
        float li_ = __uint_as_float(__builtin_amdgcn_readfirstlane(__float_as_uint(lam_init))); asm volatile("" : "+s"(li_));
        const float rn = (1.f - li_) / sqrtf(ss * (1.f / 128.f) + NORM_EPS);
        const int lane_e = lane_id_now();
        const int hh_u = lane_e >> 5, i_u = qb * 256 + wave * 32 + (lane_e & 31);
        bf16* op = mix + (size_t)(row0 + i_u) * DM + MIX_DIFF + h * 128; const float* wp = nw + h * 128 + 4 * hh_u;
#pragma unroll
        for (int db = 0; db < 4; ++db)
#pragma unroll
            for (int rp = 0; rp < 2; ++rp) { unsigned w[2][2];
#pragma unroll
                for (int q_ = 0; q_ < 2; ++q_) { const int rg = 2 * rp + q_; const f32x4 g = *(const f32x4*)(wp + 32 * db + 8 * rg);
                    w[q_][0] = cvtpk(O[0][db][4 * rg] * rn * g.x, O[0][db][4 * rg + 1] * rn * g.y); w[q_][1] = cvtpk(O[0][db][4 * rg + 2] * rn * g.z, O[0][db][4 * rg + 3] * rn * g.w); }
                store_pair16(op + 32 * db + 16 * rp, hh_u, w[0][0], w[0][1], w[1][0], w[1][1]); }
    }
#undef DF_STAGE
}

constexpr int RT_V = 8192, RT_BUF = 16384, RT_NBUF = 4, RT_Q = RT_NBUF * RT_BUF, RT_QROW = 144;
constexpr int RT_SX = RT_Q + 8 * 32 * RT_QROW;
static_assert(RT_SX + 16384 + 64 * 144 <= RING_BYTES, "retention LDS");
__device__ __forceinline__ void ret_mfma(Frame& F, const bf16* proj, bf16* mix, const float* dec_f, const float* dec_b, const float* nw, int S, int nseq, unsigned* qctr) {
    frame_refresh(F);
    const int lane = F.lane, wave = F.wave, q32 = lane & 31, hh = lane >> 5;
    LAS unsigned char* L = F.lds + RING_OFF;
    const int nqb = S / 256, nunits = nseq * RET_H * nqb, NT = S / 64;
    const int kkey = 8 * wave + (lane >> 3);
    const unsigned kgoff = (unsigned)(kkey * DIN + ((lane & 7) ^ ((kkey >> 1) & 7)) * 8);
    unsigned vgoff;
    { const int chq = lane >> 5, r7 = (lane & 31) >> 2, slot = lane & 3, x = (2 * (wave & 1) + (r7 >> 2)) & 3; vgoff = (unsigned)((8 * wave + r7) * DIN + (4 * chq + (slot ^ x)) * 8); }
    const unsigned kaddr0 = (unsigned)(q32 * 128 + (((((q32 >> 1) & 7) >> 1) << 1 | (hh ^ ((q32 >> 1) & 1))) * 16));
    const int i16 = lane & 15, q4 = i16 >> 2, p4 = i16 & 3, g1 = (lane >> 4) & 1;
    const unsigned trlo = (unsigned)(RT_V + 64 * (4 * hh + q4) + 16 * ((2 * g1 + (p4 >> 1)) ^ hh) + 8 * (p4 & 1));
    const unsigned trhi = (unsigned)(RT_V + 1024 + 64 * (4 * hh + q4) + 16 * ((2 * g1 + (p4 >> 1)) ^ ((2 + hh) & 3)) + 8 * (p4 & 1));
#define RT_STAGE(buf, tile) do { const size_t go_ = (size_t)(tile) * 64 * DIN; LAS unsigned char* Bw_ = L + (buf) * RT_BUF + wave * 1024; \
        __builtin_amdgcn_global_load_lds((const unsigned*)(kg + go_ + kgoff), (LAS unsigned*)(Bw_), 16, 0, 0); \
        __builtin_amdgcn_global_load_lds((const unsigned*)(vg + go_ + vgoff), (LAS unsigned*)(Bw_ + RT_V), 16, 0, 0); } while (0)
    for (;;) {
        const int it = q_next(qctr, (volatile LAS int*)(F.lds + MISC_OFF + 64), wave, lane); if (it >= nunits) break;
        const int qb = it % nqb, h = (it / nqb) % RET_H, s = it / (nqb * RET_H);
        const int row0 = s * S, i = qb * 256 + wave * 32 + q32;
        const float lgf = __uint_as_float(__builtin_amdgcn_readfirstlane(__float_as_uint(-log2f(1.f + expf(-dec_f[h])))));
        const float lgb = __uint_as_float(__builtin_amdgcn_readfirstlane(__float_as_uint(-log2f(1.f + expf(-dec_b[h])))));
        int lane_u = lane; asm volatile("" : "+v"(lane_u));
        const bf16* kg = proj + (size_t)row0 * DIN + C_RK + h * 64;
        const bf16* vg = proj + (size_t)row0 * DIN + C_RV + h * 64;
        { const int nL_ = 4 * qb; const int t0 = (0 < nL_ + 4 ? 0 : NT - 1 - (0 - nL_ - 4)), t1 = (1 < nL_ + 4 ? 1 : NT - 1 - (1 - nL_ - 4)), t2 = (2 < nL_ + 4 ? 2 : NT - 1 - (2 - nL_ - 4));
          RT_STAGE(0, t0); RT_STAGE(1, t1); RT_STAGE(2, t2); }
        { LAS unsigned char* Qw = L + RT_Q + wave * (32 * RT_QROW);
#pragma unroll
          for (int k = 0; k < 4; ++k) { const int idx = k * 64 + lane_u, qrow = idx >> 3, qch = idx & 7; float f[8];
              unpack8(*(const v4u*)(proj + (size_t)(row0 + qb * 256 + wave * 32 + qrow) * DIN + C_RQ + h * 64 + qch * 8), f);
              v4u w; w.x = cvtpk(f[0] * 0.125f, f[1] * 0.125f); w.y = cvtpk(f[2] * 0.125f, f[3] * 0.125f); w.z = cvtpk(f[4] * 0.125f, f[5] * 0.125f); w.w = cvtpk(f[6] * 0.125f, f[7] * 0.125f);
              *(LAS v4u*)(Qw + qrow * RT_QROW + qch * 16) = w; } }
        const LAS unsigned char* Qr = L + RT_Q + wave * (32 * RT_QROW) + q32 * RT_QROW + hh * 16;
        const unsigned tra_lo = (unsigned)(uintptr_t)L + trlo, tra_hi = (unsigned)(uintptr_t)L + trhi;
        const int nL = 4 * qb, nSteps = NT;
#define RT_TILE_OF(st) ((st) < nL + 4 ? (st) : (NT - 1 - ((st) - nL - 4)))
        f32x16 O[2], St;
#pragma unroll
        for (int r = 0; r < 16; ++r) { O[0][r] = 0.f; O[1][r] = 0.f; St[r] = 0.f; }
        int lx = lane_u; asm volatile("" : "+v"(lx));
        const int hhx = lx >> 5, q4x = (lx & 15) >> 2, p4x = lx & 3, g1x = (lx >> 4) & 1;
        const int bd = wave & 1, be = (wave >> 1) & 1, kh = wave >> 2;
        const unsigned ka_lo = (unsigned)(uintptr_t)L + (unsigned)((4 * hhx + q4x) * 128 + (((4 * bd + 2 * g1x + (p4x >> 1)) ^ ((2 * hhx + (q4x >> 1)) & 7)) * 16) + 8 * (p4x & 1));
        const unsigned ka_hi = (unsigned)(uintptr_t)L + (unsigned)((8 + 4 * hhx + q4x) * 128 + (((4 * bd + 2 * g1x + (p4x >> 1)) ^ ((4 + 2 * hhx + (q4x >> 1)) & 7)) * 16) + 8 * (p4x & 1));
        float kfs[2][8];
#pragma unroll
        for (int sx = 0; sx < 2; ++sx)
#pragma unroll
            for (int j = 0; j < 8; ++j) kfs[sx][j] = __builtin_amdgcn_exp2f(lgf * (float)(63 - (16 * (2 * kh + sx) + (j < 4 ? 4 * hhx + j : 8 + 4 * hhx + (j - 4)))));
        const float gf64 = __builtin_amdgcn_exp2f(lgf * 64.f), gb64 = __builtin_amdgcn_exp2f(lgb * 64.f);
        const int iloc = wave * 32 + (lx & 31);
        LAS float* SXF = (LAS float*)(L + RT_SX);
        LAS unsigned char* SXB = L + RT_SX + 16384;
#define RT_SIDE_DONE(rowfac) do { \
            asm volatile("s_waitcnt lgkmcnt(0)" ::: "memory"); __builtin_amdgcn_s_barrier(); asm volatile("" ::: "memory"); \
            if (kh == 1) { _Pragma("unroll") for (int r = 0; r < 16; ++r) SXF[((wave & 3) * 16 + r) * 64 + lx] = St[r]; } \
            asm volatile("s_waitcnt lgkmcnt(0)" ::: "memory"); __builtin_amdgcn_s_barrier(); asm volatile("" ::: "memory"); \
            if (kh == 0) { _Pragma("unroll") for (int rg = 0; rg < 4; ++rg) { float v_[4]; \
                    _Pragma("unroll") for (int e_ = 0; e_ < 4; ++e_) v_[e_] = St[4 * rg + e_] + SXF[((wave & 3) * 16 + 4 * rg + e_) * 64 + lx]; \
                    *(LAS unsigned long long*)(SXB + (32 * be + (lx & 31)) * 144 + (32 * bd + 8 * rg + 4 * hhx) * 2) = (unsigned long long)cvtpk(v_[0], v_[1]) | ((unsigned long long)cvtpk(v_[2], v_[3]) << 32); } } \
            asm volatile("s_waitcnt lgkmcnt(0)" ::: "memory"); __builtin_amdgcn_s_barrier(); asm volatile("" ::: "memory"); \
            { f32x16 x0, x1; _Pragma("unroll") for (int r = 0; r < 16; ++r) { x0[r] = 0.f; x1[r] = 0.f; } \
              _Pragma("unroll") for (int ds = 0; ds < 4; ++ds) { const bf16x8 qv = *(const LAS bf16x8*)(Qr + ds * 32); \
                  const bf16x8 s0 = *(const LAS bf16x8*)(SXB + (lx & 31) * 144 + ds * 32 + hhx * 16), s1 = *(const LAS bf16x8*)(SXB + (32 + (lx & 31)) * 144 + ds * 32 + hhx * 16); \
                  x0 = __builtin_amdgcn_mfma_f32_32x32x16_bf16(s0, qv, x0, 0, 0, 0); x1 = __builtin_amdgcn_mfma_f32_32x32x16_bf16(s1, qv, x1, 0, 0, 0); } \
              const float rf_ = (rowfac); _Pragma("unroll") for (int r = 0; r < 16; ++r) { O[0][r] += x0[r] * rf_; O[1][r] += x1[r] * rf_; St[r] = 0.f; } } \
        } while (0)
#pragma unroll 1
        for (int st = 0; st < nSteps; ++st) {
            const int t = RT_TILE_OF(st);
            const unsigned boff = (unsigned)((st & 3) * RT_BUF);
            const LAS unsigned char* B = L + boff;
            const unsigned tl = tra_lo + boff, th = tra_hi + boff;
            if (st + 2 < nSteps) asm volatile("s_waitcnt vmcnt(4)" ::: "memory"); else if (st + 1 < nSteps) asm volatile("s_waitcnt vmcnt(2)" ::: "memory"); else asm volatile("s_waitcnt vmcnt(0)" ::: "memory");
            __builtin_amdgcn_s_barrier(); asm volatile("" ::: "memory");
            if (st + 3 < nSteps) { const int tn = RT_TILE_OF(st + 3); RT_STAGE((st + 3) & 3, tn); }
            const bool diag = (st >= nL) && (st < nL + 4);
            if (st == nL) {
                RT_SIDE_DONE(__builtin_amdgcn_exp2f(lgf * (float)(iloc + 1)));
#pragma unroll
                for (int sx = 0; sx < 2; ++sx)
#pragma unroll
                    for (int j = 0; j < 8; ++j) kfs[sx][j] = __builtin_amdgcn_exp2f(lgb * (float)(16 * (2 * kh + sx) + (j < 4 ? 4 * hhx + j : 8 + 4 * hhx + (j - 4))));
            }
            if (!diag) {
                const float g64 = st < nL ? gf64 : gb64;
#pragma unroll
                for (int r = 0; r < 16; ++r) St[r] *= g64;
                s16x4 kl[2], khh[2], vl2[2], vh2[2];
                const unsigned kal = ka_lo + boff, kah = ka_hi + boff, tlb = tl + 512u * (unsigned)be, thb = th + 512u * (unsigned)be;
#pragma unroll
                for (int sx = 0; sx < 2; ++sx) { if (kh == 0) { TR_READ(kl[sx], kal, 2048 * sx); TR_READ(khh[sx], kah, 2048 * sx); TR_READ(vl2[sx], tlb, 2048 * sx); TR_READ(vh2[sx], thb, 2048 * sx); }
                                                 else         { TR_READ(kl[sx], kal, 2048 * (2 + sx)); TR_READ(khh[sx], kah, 2048 * (2 + sx)); TR_READ(vl2[sx], tlb, 2048 * (2 + sx)); TR_READ(vh2[sx], thb, 2048 * (2 + sx)); } }
                LGKM_WAIT(0); __builtin_amdgcn_sched_barrier(0);
#pragma unroll
                for (int sx = 0; sx < 2; ++sx) {
                    unsigned kw[4];
#pragma unroll
                    for (int d2 = 0; d2 < 2; ++d2) { const unsigned ulo = ((unsigned)(unsigned short)kl[sx][2 * d2]) | ((unsigned)(unsigned short)kl[sx][2 * d2 + 1] << 16), uhi = ((unsigned)(unsigned short)khh[sx][2 * d2]) | ((unsigned)(unsigned short)khh[sx][2 * d2 + 1] << 16);
                        kw[d2] = cvtpk(bflo(ulo) * kfs[sx][2 * d2], bfhi(ulo) * kfs[sx][2 * d2 + 1]); kw[2 + d2] = cvtpk(bflo(uhi) * kfs[sx][4 + 2 * d2], bfhi(uhi) * kfs[sx][4 + 2 * d2 + 1]); }
                    const bf16x8 af = __builtin_bit_cast(bf16x8, (v4u){kw[0], kw[1], kw[2], kw[3]});
                    St = __builtin_amdgcn_mfma_f32_32x32x16_bf16(af, VFRAG(vl2[sx], vh2[sx]), St, 0, 0, 0); }
            } else {
            const float tb = (float)(i - t * 64 - 4 * hh);
            {
                f32x16 a0, a1;
#pragma unroll
                for (int r = 0; r < 16; ++r) { a0[r] = 0.f; a1[r] = 0.f; }
#pragma unroll
                for (int ds = 0; ds < 4; ++ds) { const bf16x8 qv = *(const LAS bf16x8*)(Qr + ds * 32);
                    const bf16x8 k0 = *(const LAS bf16x8*)(B + (kaddr0 ^ (unsigned)(ds << 5))), k1 = *(const LAS bf16x8*)(B + 4096 + (kaddr0 ^ (unsigned)(ds << 5)));
                    a0 = __builtin_amdgcn_mfma_f32_32x32x16_bf16(k0, qv, a0, 0, 0, 0); a1 = __builtin_amdgcn_mfma_f32_32x32x16_bf16(k1, qv, a1, 0, 0, 0); }
                s16x4 vl[2][4], vh[2][4];
                __builtin_amdgcn_sched_barrier(0);
#pragma unroll
                for (int db = 0; db < 2; ++db)
#pragma unroll
                    for (int ks = 0; ks < 4; ++ks) { TR_READ(vl[db][ks], tl, 2048 * ks + 512 * db); TR_READ(vh[db][ks], th, 2048 * ks + 512 * db); }
                __builtin_amdgcn_sched_barrier(0);
#pragma unroll
                for (int r = 0; r < 16; ++r) { const float t0 = tb - (float)((r & 3) + 8 * (r >> 2)), t1 = t0 - 32.f;
                    a0[r] *= __builtin_amdgcn_exp2f(fabsf(t0) * (t0 >= 0.f ? lgf : lgb)); a1[r] *= __builtin_amdgcn_exp2f(fabsf(t1) * (t1 >= 0.f ? lgf : lgb)); }
                bf16x8 pf[4];
#pragma unroll
                for (int sI = 0; sI < 2; ++sI) { v4u w; w.x = cvtpk(a0[8 * sI], a0[8 * sI + 1]); w.y = cvtpk(a0[8 * sI + 2], a0[8 * sI + 3]); w.z = cvtpk(a0[8 * sI + 4], a0[8 * sI + 5]); w.w = cvtpk(a0[8 * sI + 6], a0[8 * sI + 7]);
                    pf[sI] = __builtin_bit_cast(bf16x8, w);
                    v4u x; x.x = cvtpk(a1[8 * sI], a1[8 * sI + 1]); x.y = cvtpk(a1[8 * sI + 2], a1[8 * sI + 3]); x.z = cvtpk(a1[8 * sI + 4], a1[8 * sI + 5]); x.w = cvtpk(a1[8 * sI + 6], a1[8 * sI + 7]);
                    pf[2 + sI] = __builtin_bit_cast(bf16x8, x); }
                __builtin_amdgcn_sched_barrier(0); LGKM_WAIT(0); __builtin_amdgcn_sched_barrier(0);
#pragma unroll
                for (int ks = 0; ks < 4; ++ks)
#pragma unroll
                    for (int db = 0; db < 2; ++db) O[db] = __builtin_amdgcn_mfma_f32_32x32x16_bf16(VFRAG(vl[db][ks], vh[db][ks]), pf[ks], O[db], 0, 0, 0);
            }
            }
            asm volatile("s_waitcnt lgkmcnt(0)" ::: "memory");
        }
        RT_SIDE_DONE(__builtin_amdgcn_exp2f(lgb * (float)(256 - iloc)));
#undef RT_SIDE_DONE
#undef RT_TILE_OF
        float sm = 0.f;
#pragma unroll
        for (int db = 0; db < 2; ++db)
#pragma unroll
            for (int r = 0; r < 16; ++r) sm += O[db][r];
        const float mean = half_sum(sm) * (1.f / 64.f); float var = 0.f;
#pragma unroll
        for (int db = 0; db < 2; ++db)
#pragma unroll
            for (int r = 0; r < 16; ++r) { O[db][r] -= mean; var += O[db][r] * O[db][r]; }
        const float rstd = 1.f / sqrtf(half_sum(var) * (1.f / 64.f) + NORM_EPS);
        const int hh_u = lane_u >> 5, i_u = qb * 256 + wave * 32 + (lane_u & 31);
        const bf16* gp = proj + (size_t)(row0 + i_u) * DIN + C_RG + h * 64 + 4 * hh_u; bf16* op = mix + (size_t)(row0 + i_u) * DM + MIX_RET + h * 64; const float* wp = nw + h * 64 + 4 * hh_u;
#pragma unroll
        for (int db = 0; db < 2; ++db)
#pragma unroll
            for (int rp = 0; rp < 2; ++rp) { unsigned w[2][2];
#pragma unroll
              for (int q_ = 0; q_ < 2; ++q_) { const int rg = 2 * rp + q_; const f32x4 gw = *(const f32x4*)(wp + 32 * db + 8 * rg); const unsigned long long gv = *(const unsigned long long*)(gp + 32 * db + 8 * rg);
                const float g0 = bflo((unsigned)gv), g1_ = bfhi((unsigned)gv), g2 = bflo((unsigned)(gv >> 32)), g3 = bfhi((unsigned)(gv >> 32));
                const float y0 = O[db][4 * rg] * rstd * gw.x * (g0 / (1.f + __expf(-g0))), y1 = O[db][4 * rg + 1] * rstd * gw.y * (g1_ / (1.f + __expf(-g1_)));
                const float y2 = O[db][4 * rg + 2] * rstd * gw.z * (g2 / (1.f + __expf(-g2))), y3 = O[db][4 * rg + 3] * rstd * gw.w * (g3 / (1.f + __expf(-g3)));
                w[q_][0] = cvtpk(y0, y1); w[q_][1] = cvtpk(y2, y3); }
              store_pair16(op + 32 * db + 16 * rp, hh_u, w[0][0], w[0][1], w[1][0], w[1][1]); }
    }
#undef RT_STAGE
}

constexpr int NA_TBL = RT_Q + 8 * 32 * RT_QROW, NA_TROW = 160;
static_assert(NA_TBL + 15 * NA_TROW * 4 <= RING_BYTES, "NA LDS");
__device__ __forceinline__ void na_mfma(Frame& F, const bf16* proj, bf16* mix, const float* rpb, int S, int nseq, unsigned* qctr) {
    frame_refresh(F);
    const int lane = F.lane, wave = F.wave, q32 = lane & 31, hh = lane >> 5;
    LAS unsigned char* L = F.lds + RING_OFF;
    const int rows = S / 64, nrq = rows / 4, nunits = nseq * NA_H * nrq;
    const int kkey = 8 * wave + (lane >> 3);
    const unsigned kgoff = (unsigned)(kkey * DIN + ((lane & 7) ^ ((kkey >> 1) & 7)) * 8);
    unsigned vgoff;
    { const int chq = lane >> 5, r7 = (lane & 31) >> 2, slot = lane & 3, x = (2 * (wave & 1) + (r7 >> 2)) & 3; vgoff = (unsigned)((8 * wave + r7) * DIN + (4 * chq + (slot ^ x)) * 8); }
    const int blk = wave & 3, rp = wave >> 2, qc = 16 * blk + (q32 & 15);
    const int cb = (16 * blk - 8) < 0 ? 0 : ((16 * blk - 8) > 32 ? 32 : (16 * blk - 8));
    const int cs = (qc - 8) < 0 ? 0 : ((qc - 8) > 48 ? 48 : (qc - 8));
    const int kcol = cb + q32;
    const unsigned kaddr0 = (unsigned)(kcol * 128 + (((((kcol >> 1) & 7) >> 1) << 1 | (hh ^ ((kcol >> 1) & 1))) * 16));
    const int i16 = lane & 15, q4 = i16 >> 2, p4 = i16 & 3, g1 = (lane >> 4) & 1, pc0 = cb >> 3;
    const unsigned trlo = (unsigned)(RT_V + pc0 * 1024 + 64 * (4 * hh + q4) + 16 * ((2 * g1 + (p4 >> 1)) ^ ((2 * (pc0 & 1) + hh) & 3)) + 8 * (p4 & 1));
    const unsigned trhi = (unsigned)(RT_V + (pc0 + 1) * 1024 + 64 * (4 * hh + q4) + 16 * ((2 * g1 + (p4 >> 1)) ^ ((2 * ((pc0 + 1) & 1) + hh) & 3)) + 8 * (p4 & 1));
    const int vbase = cb + 4 * hh - cs;
    const unsigned tbase = (unsigned)(NA_TBL + (64 + 15 + cb + 4 * hh - qc) * 4);
    const float qsc = 0.125f * LOG2E;
#define NA_STAGE(buf, krow) do { const size_t go_ = (size_t)(krow) * 64 * DIN; LAS unsigned char* Bw_ = L + (buf) * RT_BUF + wave * 1024; \
        __builtin_amdgcn_global_load_lds((const unsigned*)(kg + go_ + kgoff), (LAS unsigned*)(Bw_), 16, 0, 0); \
        __builtin_amdgcn_global_load_lds((const unsigned*)(vg + go_ + vgoff), (LAS unsigned*)(Bw_ + RT_V), 16, 0, 0); } while (0)
    for (;;) {
        const int it = q_next(qctr, (volatile LAS int*)(F.lds + MISC_OFF + 64), wave, lane); if (it >= nunits) break;
        const int rq = it % nrq, h = (it / nrq) % NA_H, s = it / (nrq * NA_H);
        const int row0 = s * S;
        int lane_u = lane; asm volatile("" : "+v"(lane_u));
        const int r = 4 * rq + 2 * rp + ((lane_u & 31) >> 4);
        int rs = r - 4; rs = rs < 0 ? 0 : (rs > rows - 8 ? rows - 8 : rs);
        int rw0 = 4 * rq + 2 * rp - 4; rw0 = rw0 < 0 ? 0 : (rw0 > rows - 8 ? rows - 8 : rw0);
        int rw1 = 4 * rq + 2 * rp - 3; rw1 = rw1 < 0 ? 0 : (rw1 > rows - 8 ? rows - 8 : rw1); rw1 += 8;
        int rlo = 4 * rq - 4; rlo = rlo < 0 ? 0 : (rlo > rows - 8 ? rows - 8 : rlo);
        int rhi = 4 * rq - 1; rhi = rhi < 0 ? 0 : (rhi > rows - 8 ? rows - 8 : rhi); rhi += 8;
        const int NTu = rhi - rlo;
        const bf16* kg = proj + (size_t)row0 * DIN + C_NK + h * 64;
        const bf16* vg = proj + (size_t)row0 * DIN + C_NV + h * 64;
        NA_STAGE(0, rlo); NA_STAGE(1, rlo + 1); NA_STAGE(2, rlo + 2);
        bf16x8 qf[4];
        { const bf16* qp = proj + (size_t)(row0 + r * 64 + 16 * blk + (lane_u & 15)) * DIN + C_NQ + h * 64 + (lane_u >> 5) * 8;
#pragma unroll
          for (int ds = 0; ds < 4; ++ds) { float f[8]; unpack8(*(const v4u*)(qp + ds * 16), f);
              v4u w; w.x = cvtpk(f[0] * qsc, f[1] * qsc); w.y = cvtpk(f[2] * qsc, f[3] * qsc); w.z = cvtpk(f[4] * qsc, f[5] * qsc); w.w = cvtpk(f[6] * qsc, f[7] * qsc);
              qf[ds] = __builtin_bit_cast(bf16x8, w); } }
        { const int tix = wave * 64 + lane_u;
          if (tix < 15 * 31) { const int dr = tix / 31, dc = tix % 31; *(LAS float*)(L + NA_TBL + (dr * NA_TROW + 64 + dc) * 4) = rpb[h * 15 * 31 + tix] * LOG2E; }
          for (int p = tix; p < 15 * NA_TROW; p += NTHREADS) { const int dc = p % NA_TROW - 64; if (!((unsigned)dc < 31u)) *(LAS float*)(L + NA_TBL + p * 4) = 0.f; } }
        const unsigned tra_lo = (unsigned)(uintptr_t)L + trlo, tra_hi = (unsigned)(uintptr_t)L + trhi;
        f32x16 O[2];
#pragma unroll
        for (int db = 0; db < 2; ++db)
#pragma unroll
            for (int rr = 0; rr < 16; ++rr) O[db][rr] = 0.f;
        float m = 0.f, l = 0.f;
        float madd[16];
        { int vb = vbase; asm volatile("" : "+v"(vb));
#pragma unroll
          for (int rr = 0; rr < 16; ++rr) madd[rr] = ((unsigned)(vb + (rr & 3) + 8 * (rr >> 2)) < 16u) ? 0.f : -3e30f; }
#pragma unroll 1
        for (int t4 = 0; t4 < NTu; t4 += RT_NBUF) {
#pragma unroll
          for (int tb_ = 0; tb_ < RT_NBUF; ++tb_) {
            const int t = t4 + tb_;
            if (t < NTu) {
            const int kr = rlo + t;
            const LAS unsigned char* B = L + tb_ * RT_BUF;
            if (t + 2 < NTu) asm volatile("s_waitcnt vmcnt(4)" ::: "memory"); else if (t + 1 < NTu) asm volatile("s_waitcnt vmcnt(2)" ::: "memory"); else asm volatile("s_waitcnt vmcnt(0)" ::: "memory");
            __builtin_amdgcn_s_barrier(); asm volatile("" ::: "memory");
            if (t + 3 < NTu) NA_STAGE((tb_ + 3) & 3, kr + 3);
            if (kr >= rw0 && kr < rw1) {
                bf16x8 kf[4];
#pragma unroll
                for (int ds = 0; ds < 4; ++ds) kf[ds] = *(const LAS bf16x8*)(B + (kaddr0 ^ (unsigned)(ds << 5)));
                s16x4 vl[2][2], vh[2][2];
#pragma unroll
                for (int db = 0; db < 2; ++db)
#pragma unroll
                    for (int ks = 0; ks < 2; ++ks) { TR_READ(vl[db][ks], tra_lo, tb_ * RT_BUF + 2048 * ks + 512 * db); TR_READ(vh[db][ks], tra_hi, tb_ * RT_BUF + 2048 * ks + 512 * db); }
                int drl = kr - r + 7; const float rm = ((unsigned)(kr - rs) < 8u ? 0.f : -3e30f) - m;
                drl = drl < 0 ? 0 : (drl > 14 ? 14 : drl);
                const unsigned trow = tbase + (unsigned)(drl * NA_TROW * 4);
                f32x16 a0;
#pragma unroll
                for (int rr = 0; rr < 16; ++rr) { const int ko = (rr & 3) + 8 * (rr >> 2); a0[rr] = (*(const LAS float*)(L + trow + ko * 4) + madd[rr]) + rm; }
                __builtin_amdgcn_sched_barrier(0); LGKM_WAIT(0); __builtin_amdgcn_sched_barrier(0);
#pragma unroll
                for (int ds = 0; ds < 4; ++ds) a0 = __builtin_amdgcn_mfma_f32_32x32x16_bf16(kf[ds], qf[ds], a0, 0, 0, 0);
                float ls = 0.f;
#pragma unroll
                for (int rr = 0; rr < 16; ++rr) { const float p0 = __builtin_amdgcn_exp2f(a0[rr]); ls += p0; a0[rr] = p0; }
                if (__builtin_expect(__any(ls > 65536.f), 0)) {
                    const int e_ = __builtin_amdgcn_frexp_expf(ls) - 1; const float dl = half_max((float)(e_ > 0 ? e_ : 0)), alpha = __builtin_amdgcn_exp2f(-dl);
                    m += dl; l *= alpha; ls *= alpha;
#pragma unroll
                    for (int rr = 0; rr < 16; ++rr) a0[rr] *= alpha;
#pragma unroll
                    for (int db = 0; db < 2; ++db)
#pragma unroll
                        for (int rr = 0; rr < 16; ++rr) O[db][rr] *= alpha; }
                l += ls;
                bf16x8 pf[2];
#pragma unroll
                for (int sI = 0; sI < 2; ++sI) { v4u w; w.x = cvtpk(a0[8 * sI], a0[8 * sI + 1]); w.y = cvtpk(a0[8 * sI + 2], a0[8 * sI + 3]); w.z = cvtpk(a0[8 * sI + 4], a0[8 * sI + 5]); w.w = cvtpk(a0[8 * sI + 6], a0[8 * sI + 7]);
                    pf[sI] = __builtin_bit_cast(bf16x8, w); }
#pragma unroll
                for (int ks = 0; ks < 2; ++ks)
#pragma unroll
                    for (int db = 0; db < 2; ++db) O[db] = __builtin_amdgcn_mfma_f32_32x32x16_bf16(VFRAG(vl[db][ks], vh[db][ks]), pf[ks], O[db], 0, 0, 0);
            }
            asm volatile("s_waitcnt lgkmcnt(0)" ::: "memory");
            }
          }
        }
        const float inv = 1.f / half_sum(l);
        const int hh_u = lane_u >> 5;
        bf16* op = mix + (size_t)(row0 + r * 64 + 16 * blk + (lane_u & 15)) * DM + MIX_NA + h * 64;
#pragma unroll
        for (int db = 0; db < 2; ++db)
#pragma unroll
            for (int rp = 0; rp < 2; ++rp)
                store_pair16(op + 32 * db + 16 * rp, hh_u, cvtpk(O[db][8 * rp] * inv, O[db][8 * rp + 1] * inv), cvtpk(O[db][8 * rp + 2] * inv, O[db][8 * rp + 3] * inv),
                                                            cvtpk(O[db][8 * rp + 4] * inv, O[db][8 * rp + 5] * inv), cvtpk(O[db][8 * rp + 6] * inv, O[db][8 * rp + 7] * inv));
    }
#undef NA_STAGE
}

struct Args { const float* in[20]; float* out; unsigned char* ws; };
__global__ void __launch_bounds__(NTHREADS, 2) fwd_kernel(Args args) {
    extern __shared__ __attribute__((aligned(16))) unsigned char lds[];
    Frame F;
    F.lds = (LAS unsigned char*)lds;
    F.tid = threadIdx.x; F.lane = F.tid & 63; F.wave = __builtin_amdgcn_readfirstlane(F.tid >> 6);
    F.G = gridDim.x; F.bx = blockIdx.x;
    unsigned char* ws = args.ws;
    for (int u = F.tid; u < (LDS_BYTES - LDSCTL_OFF) / 4; u += NTHREADS) ((LAS unsigned*)(F.lds + LDSCTL_OFF))[u] = 0u;
    __syncthreads();
    XcdBarrier bar = xcd_barrier_post((unsigned*)(ws + WS_CTL) + CW_BAR, (volatile LAS unsigned*)(F.lds + MISC_OFF) + 8, F.wave);
#define GRID_BAR() xcd_barrier(bar)
    const bool chunked = (gridDim.x & 7u) == 0u && gridDim.x >= 16u;
    if (chunked) (void)xcd_barrier_post((unsigned*)(ws + WS_HBAR) + (blockIdx.x & 7u) * 4096u, (volatile LAS unsigned*)(F.lds + MISC_OFF) + 12, F.wave, gridDim.x >> 3);
#define CHUNK_BAR() do { if ((Gv & 7) == 0 && Gv >= 16) { XcdBarrier hb_; hb_.bar = (unsigned*)(ws + WS_HBAR) + ((unsigned)bx & 7u) * 4096u; hb_.x = xb_xcc_id(); hb_.st = (volatile LAS unsigned*)(F.lds + MISC_OFF) + 12; \
        hb_.wave = F.wave; hb_.np = (unsigned)Gv >> 3; xcd_barrier(hb_); } else GRID_BAR(); } while (0)

    unsigned char* ob = (unsigned char*)args.out;
    bf16* W_in = (bf16*)(ws + WS_WIN); bf16* W_out = (bf16*)(ob + OUT_WOUT); bf16* W_up = (bf16*)(ws + WS_WUP); bf16* W_dn = (bf16*)(ob + OUT_WDN);
    bf16* XB = (bf16*)(ws + WS_H); bf16* MIXb = (bf16*)(ob + OUT_MIX); bf16* PROJ = (bf16*)(ws + WS_PROJ); bf16* ACT = (bf16*)(ws + WS_PROJ);
    float* EPb = (float*)(ws + WS_ACT); float* EAb = EPb + (size_t)(MT / 256) * 2 * DFF; float* EGb = EAb + (size_t)(MT / 256) * 2 * DFF;
    ssq_t* SS = (ssq_t*)(ws + WS_SS);

    transpose_matrix<false>(F, args.in[3], DM, DIN, W_in, args.in[2]);
    convert_rows(F, args.in[0], XB, SS, MG);
    convert_rows(F, args.in[1], XB + (size_t)MG * DM, SS + MG, MG);
    GRID_BAR();

    for (int l = 0; l < DEPTH; ++l) {
        int bx = (int)blockIdx.x, Gv = (int)gridDim.x; asm volatile("" : "+s"(bx), "+s"(Gv)); F.G = Gv; F.bx = bx;
        { pg8::Gemm gm{XB, W_in + (size_t)l * DIN * DM, MT, DIN, DM}; pg8::StaticOrder SO; SO.init(MT, DIN, F.G, bx);
          EpiBf16Scale E{PROJ, DIN, SS + (size_t)(2 * l) * MT};
          pg8::gemm_phase<EpiBf16Scale, pg8::StaticOrder, true, true>(F.lds + RING_OFF, gm, SO, E, F.wave); }
        GRID_BAR();
        {
            float li_v = 0.8f - 0.6f * expf(-0.3f * (float)l); asm volatile("" : "+v"(li_v));
            unsigned li_u = __builtin_amdgcn_readfirstlane(__float_as_uint(li_v)); asm volatile("" : "+s"(li_u));
            const float lam_init = __uint_as_float(li_u);
            const float d1 = wave_sum(args.in[8][l * 64 + F.lane] * args.in[9][l * 64 + F.lane]);
            const float d2 = wave_sum(args.in[10][l * 64 + F.lane] * args.in[11][l * 64 + F.lane]);
            const float lam = __uint_as_float(__builtin_amdgcn_readfirstlane(__float_as_uint(expf(d1) - expf(d2) + lam_init)));
            unsigned* qc = (unsigned*)(ws + WS_CTL) + CW_QUEUE + l * 6 * 64;
            const bf16* P1 = PROJ + (size_t)MG * DIN; bf16* M1 = MIXb + (size_t)MG * DM;
            if (l == 0) { const int nbg = Gv < NBG ? Gv : NBG;
              if (bx < nbg) { F.G = nbg;
                for (int l2 = 0; l2 < DEPTH; ++l2) {
                    if (l2 > 0) transpose_matrix<false>(F, args.in[3] + (size_t)l2 * DM * DIN, DM, DIN, W_in + (size_t)l2 * DIN * DM, args.in[2] + l2 * DM);
                    transpose_matrix<false>(F, args.in[13] + (size_t)l2 * DM * DM, DM, DM, W_out + (size_t)l2 * DM * DM, nullptr);
                    transpose_matrix<true>(F, args.in[15] + (size_t)l2 * DM * DUP, DM, DUP, W_up + (size_t)l2 * DUP * DM, args.in[14] + l2 * DM);
                    transpose_matrix<false>(F, args.in[18] + (size_t)l2 * DFF * DM, DFF, DM, W_dn + (size_t)l2 * DM * DFF, nullptr); }
                F.G = Gv; asm volatile("s_waitcnt vmcnt(0) lgkmcnt(0)" ::: "memory"); __syncthreads(); } }
            if (F.wave >= 4) __builtin_amdgcn_s_setprio(1);
            diff_mfma(F, P1, M1, args.in[12] + l * 768, lam, lam_init, 4096, 4, qc);
            diff_mfma(F, PROJ, MIXb, args.in[12] + l * 768, lam, lam_init, 2048, 8, qc + 64);
            ret_mfma(F, P1, M1, args.in[4] + l * 8, args.in[5] + l * 8, args.in[6] + l * 512, 4096, 4, qc + 128);
            ret_mfma(F, PROJ, MIXb, args.in[4] + l * 8, args.in[5] + l * 8, args.in[6] + l * 512, 2048, 8, qc + 192);
            na_mfma(F, P1, M1, args.in[7] + l * NA_H * 15 * 31, 4096, 4, qc + 256);
            na_mfma(F, PROJ, MIXb, args.in[7] + l * NA_H * 15 * 31, 2048, 8, qc + 320);
            __builtin_amdgcn_s_setprio(0);
        }
        GRID_BAR();
        { pg8::Gemm gm{MIXb, W_out + (size_t)l * DM * DM, MT, DM, DM}; pg8::StaticOrder SO; SO.init(MT, DM, F.G, bx);
          EpiResNorm E{XB, XB, SS + (size_t)(2 * l + 1) * MT, DM};
          pg8::gemm_phase<EpiResNorm, pg8::StaticOrder, true, true>(F.lds + RING_OFF, gm, SO, E, F.wave); }
        CHUNK_BAR();
        { pg8::Gemm gm{XB, W_up + (size_t)l * DUP * DM, MT, DUP, DM}; pg8::StaticOrder SO; SO.init(MT, DUP, F.G, bx);
          EpiUpConv E{ACT, SS + (size_t)(2 * l + 1) * MT, args.in[16] + (size_t)l * 3 * DFF, args.in[17] + (size_t)l * DFF, EPb, EAb, EGb, F.lds + RING_OFF};
          pg8::gemm_phase<EpiUpConv, pg8::StaticOrder, true, true>(F.lds + RING_OFF, gm, SO, E, F.wave); }
        CHUNK_BAR();
        { pg8::Gemm gm{ACT, W_dn + (size_t)l * DM * DFF, MT, DM, DFF}; pg8::StaticOrder SO; SO.init(MT, DM, F.G, bx);
          { frame_refresh(F); pg8::Unit uu; int lastpm = -1;
            for (int ui = 0; SO.next(ui, uu); ++ui) if (uu.pm != lastpm) { ffn_edge_fixup_panel(F, ACT, EPb, EAb, EGb, args.in[16] + (size_t)l * 3 * DFF, uu.pm < MG / 256 ? 2048 : 4096, uu.pm); lastpm = uu.pm; }
            asm volatile("s_waitcnt vmcnt(0)" ::: "memory"); __syncthreads(); }
          EpiResNorm E{XB, XB, SS + (size_t)(2 * l + 2) * MT, DM};
          pg8::gemm_phase<EpiResNorm, pg8::StaticOrder, true, true>(F.lds + RING_OFF, gm, SO, E, F.wave); }
        GRID_BAR();
    }
    final_norm_rows(F, XB, SS + (size_t)4 * MT, args.in[19], args.out, MT);
}

extern "C" void kernel_launch(void* const* d_in, const int* in_sizes, int n_in, void* d_out, int out_size, void* d_ws, size_t ws_size, hipStream_t stream) {
    static int grid = 0;
    if (grid == 0) {
        if (n_in != 20 || out_size != 2 * MG * DM || ws_size < WS_END) { fprintf(stderr, "kernel_launch: unexpected shapes / workspace (n_in %d out %d ws %zu); nothing launched\n", n_in, out_size, ws_size); grid = -1; return; }
        int dev = 0, cus = 0, per_cu = 0;
        if (hipGetDevice(&dev) != hipSuccess || hipDeviceGetAttribute(&cus, hipDeviceAttributeMultiprocessorCount, dev) != hipSuccess) { grid = -1; return; }
        if (hipFuncSetAttribute((const void*)fwd_kernel, hipFuncAttributeMaxDynamicSharedMemorySize, LDS_BYTES) != hipSuccess) { fprintf(stderr, "kernel_launch: hipFuncSetAttribute failed\n"); grid = -1; return; }
        if (hipOccupancyMaxActiveBlocksPerMultiprocessor(&per_cu, (const void*)fwd_kernel, NTHREADS, LDS_BYTES) != hipSuccess || per_cu < 1) { fprintf(stderr, "kernel_launch: occupancy query reports %d\n", per_cu); }
        (void)hipGetLastError();
        grid = cus;
    }
    if (grid < 0) return;
    if (hipMemsetAsync((char*)d_ws + WS_CTL, 0, CTL_ZERO_BYTES, stream) != hipSuccess) return;
    Args a{};
    for (int i = 0; i < 20; ++i) a.in[i] = (const float*)d_in[i];
    a.out = (float*)d_out; a.ws = (unsigned char*)d_ws;
    hipLaunchKernelGGL(fwd_kernel, dim3(grid), dim3(NTHREADS), LDS_BYTES, stream, a);
}
```

```cpp
#include <hip/hip_runtime.h>
#include <cstdio>
#include <cstdint>

__device__ __forceinline__ int lane_id_now() { int ln; asm volatile("v_mbcnt_lo_u32_b32 %0, -1, 0\n\tv_mbcnt_hi_u32_b32 %0, -1, %0" : "=v"(ln)); return ln; }
namespace pg8 {
#define PG8_LAS __attribute__((address_space(3)))
typedef unsigned short bf16_t;
typedef short bf16x8 __attribute__((ext_vector_type(8)));
typedef float f32x4 __attribute__((ext_vector_type(4)));
typedef unsigned u32x4 __attribute__((ext_vector_type(4)));
constexpr int BM = 256, BK = 64, HALF = 128, HTB = HALF * BK * 2  , STAGE_BYTES = 8 * HTB, NXCD = 8, WGM = 8;

__host__ __device__ __forceinline__ int lds_byte(int r, int c) { const int st = (r >> 4) * 2 + (c >> 5), rr = r & 15, cc = c & 31, ob = rr * 64 + cc * 2; return st * 1024 + (ob ^ (((ob >> 9) & 1) << 5)); }
__host__ __device__ __forceinline__ void stage_rc(int b, int& R, int& C) { const int st = b / 1024, sb = b % 1024, swz = sb ^ (((sb >> 9) & 1) << 5); R = (st >> 1) * 16 + swz / 64; C = (st & 1) * 32 + (swz % 64) / 2; }
__host__ __device__ __forceinline__ int perm32(int rho) { const int n = rho >> 4, i = rho & 15; return 8 * (i >> 2) + 4 * n + (i & 3); }

struct Unit { int pm, pn; };
struct Gemm { const bf16_t* A; const bf16_t* Bt; int M, N, K; };

struct StaticOrder {
    int nM, nN, nwg, G, c;
    __host__ __device__ void init(int M, int N, int G_, int c_) { nM = M / BM; nN = N / BM; nwg = nM * nN; G = G_; c = c_; }
    __host__ __device__ bool next(int i, Unit& u) const {
        const long L = (long)i * G + c; if (L >= nwg) return false;
        int wgid = (int)L; { const int q = nwg / NXCD, r = nwg % NXCD, xcd = wgid % NXCD, off = wgid / NXCD; wgid = (xcd < r ? xcd * (q + 1) : r * (q + 1) + (xcd - r) * q) + off; }
        const int nig = WGM * nN, gid = wgid / nig, fm = gid * WGM, gsz = (nM - fm) < WGM ? (nM - fm) : WGM;
        u.pm = fm + ((wgid % nig) % gsz); u.pn = (wgid % nig) / gsz; return true;
    }
    __device__ __forceinline__ void a_ready(const Unit&) const {}
    __device__ __forceinline__ void done(const Unit&) const {}
};

__device__ __forceinline__ unsigned cvt_pk_bf16(float lo, float hi) { unsigned r; asm volatile("v_cvt_pk_bf16_f32 %0, %1, %2" : "=v"(r) : "v"(lo), "v"(hi)); return r; }

template <class Epi, class Sched, bool ALIGN_EPI = false, bool SP2 = false>
__device__ __forceinline__ void gemm_phase(PG8_LAS unsigned char* lds, const Gemm g, const Sched& S, const Epi& E, int wave_id) {
    int tid_ = wave_id * 64 + lane_id_now();
    const int tid = tid_, wid = __builtin_amdgcn_readfirstlane(tid >> 6), lane = tid & 63, wr = wid >> 2, wc = wid & 3, fr = lane & 15, fq = lane >> 4;
    const int K = g.K, nt = K / BK;
    unsigned voffA[2], voffB[2];
#pragma unroll
    for (int i = 0; i < 2; ++i) { int R, C; stage_rc(tid * 16 + i * 8192, R, C); const int Rb = Epi::PERM ? ((R & ~31) + perm32(R & 31)) : R;
        voffA[i] = (unsigned)(R * K + C) * 2u; voffB[i] = (unsigned)(Rb * K + C) * 2u; }
    const size_t kstep = (size_t)(BK * 2);
    const size_t hstep = (size_t)HALF * K * 2;
    const size_t tstep = 2 * hstep;
    const unsigned ldsw = (unsigned)wid * 1024u;
    const int aoff = lds_byte(wr * 64 + fr, fq * 8), boff = lds_byte(wc * 32 + fr, fq * 8);
#define PG8_SA(b, h) (((b) * 2 + (h)) * HTB)
#define PG8_SB(b, h) ((4 + (b) * 2 + (h)) * HTB)
#define PG8_STAGE(bufoff, gbase, voff) do { _Pragma("unroll") for (int _i = 0; _i < 2; ++_i) \
        __builtin_amdgcn_global_load_lds((const unsigned*)((const char*)(gbase) + (voff)[_i]), (PG8_LAS unsigned*)(lds + (bufoff) + ldsw + _i * 8192), 16, 0, 0); } while (0)
#define PG8_LDA(dst, b, h) do { _Pragma("unroll") for (int m = 0; m < 4; ++m) _Pragma("unroll") for (int k = 0; k < 2; ++k) dst[m][k] = *(const PG8_LAS bf16x8*)(lds + PG8_SA(b, h) + aoff + m * 2048 + k * 1024); } while (0)
#define PG8_LDB(dst, b, h) do { _Pragma("unroll") for (int n = 0; n < 2; ++n) _Pragma("unroll") for (int k = 0; k < 2; ++k) dst[n][k] = *(const PG8_LAS bf16x8*)(lds + PG8_SB(b, h) + boff + n * 2048 + k * 1024); } while (0)
#define PG8_MMA(ai, bj, At, Bt) do { __builtin_amdgcn_s_setprio(1); _Pragma("unroll") for (int m = 0; m < 4; ++m) _Pragma("unroll") for (int n = 0; n < 2; ++n) _Pragma("unroll") for (int k = 0; k < 2; ++k) \
        acc[ai][bj][m][n] = __builtin_amdgcn_mfma_f32_16x16x32_bf16(Bt[n][k], At[m][k], acc[ai][bj][m][n], 0, 0, 0); __builtin_amdgcn_s_setprio(0); } while (0)
#define PG8_WAIT_V(n) asm volatile("s_waitcnt vmcnt(" #n ")" ::: "memory")
#define PG8_WAIT_L(n) asm volatile("s_waitcnt lgkmcnt(" #n ")" ::: "memory")
#define PG8_BAR __builtin_amdgcn_s_barrier()
#define PG8_SCHED __builtin_amdgcn_sched_barrier(0)
    Unit cur, nxt; int ui = 0;
    if (!S.next(0, cur)) return;
    f32x4 acc[2][2][4][2];
#pragma unroll
    for (int a = 0; a < 2; ++a)
#pragma unroll
        for (int b = 0; b < 2; ++b)
#pragma unroll
            for (int m = 0; m < 4; ++m)
#pragma unroll
                for (int n = 0; n < 2; ++n) acc[a][b][m][n] = (f32x4){0.f, 0.f, 0.f, 0.f};
    bf16x8 At[4][2], B0[2][2], B1[2][2];
    const char* cA = (const char*)g.A + (size_t)cur.pm * tstep; const char* cB = (const char*)g.Bt + (size_t)cur.pn * tstep;
    S.a_ready(cur);
    if constexpr (SP2) {
        PG8_STAGE(PG8_SB(0, 0), cB, voffB); PG8_STAGE(PG8_SB(0, 1), cB + hstep, voffB); PG8_STAGE(PG8_SA(0, 0), cA, voffA); PG8_STAGE(PG8_SA(0, 1), cA + hstep, voffA);
        if (wr == 1) PG8_BAR;
        PG8_WAIT_V(2); PG8_BAR;
        PG8_STAGE(PG8_SB(1, 0), cB + kstep, voffB); PG8_STAGE(PG8_SA(1, 0), cA + kstep, voffA); PG8_STAGE(PG8_SB(1, 1), cB + hstep + kstep, voffB);
        PG8_WAIT_V(6); PG8_BAR;
    } else {
        PG8_STAGE(PG8_SB(0, 0), cB, voffB); PG8_STAGE(PG8_SA(0, 0), cA, voffA); PG8_STAGE(PG8_SB(0, 1), cB + hstep, voffB); PG8_STAGE(PG8_SA(0, 1), cA + hstep, voffA);
        if (wr == 1) PG8_BAR;
        PG8_WAIT_V(4); PG8_BAR;
        PG8_STAGE(PG8_SB(1, 0), cB + kstep, voffB); PG8_STAGE(PG8_SA(1, 0), cA + kstep, voffA); PG8_STAGE(PG8_SB(1, 1), cB + hstep + kstep, voffB);
        PG8_WAIT_V(6); PG8_BAR;
    }
    for (;;) {
        const bool has_next = S.next(ui + 1, nxt);
        const char* nA = has_next ? (const char*)g.A + (size_t)nxt.pm * tstep : cA; const char* nB = has_next ? (const char*)g.Bt + (size_t)nxt.pn * tstep : cB;
        for (int t = 0; t < nt; t += 2) {
            const bool last = (t == nt - 2);
            const char* a1 = cA + (size_t)(t + 1) * kstep;
            const char* a2 = last ? nA : cA + (size_t)(t + 2) * kstep; const char* b2 = last ? nB : cB + (size_t)(t + 2) * kstep;
            const char* a3 = a2 + kstep; const char* b3 = b2 + kstep;
            if (last && has_next) S.a_ready(nxt);
            if constexpr (SP2) {
            PG8_LDB(B0, 0, 0); PG8_LDB(B1, 0, 1); PG8_SCHED; PG8_LDA(At, 0, 0); PG8_STAGE(PG8_SA(1, 1), a1 + hstep, voffA);
            PG8_WAIT_V(8); PG8_WAIT_L(0); PG8_BAR; PG8_MMA(0, 0, At, B0); PG8_MMA(0, 1, At, B1); PG8_BAR; PG8_SCHED;
            PG8_LDA(At, 0, 1); PG8_STAGE(PG8_SB(0, 0), b2, voffB); PG8_STAGE(PG8_SB(0, 1), b2 + hstep, voffB); PG8_STAGE(PG8_SA(0, 0), a2, voffA);
            PG8_WAIT_V(8); PG8_WAIT_L(0); PG8_BAR; PG8_MMA(1, 0, At, B0); PG8_MMA(1, 1, At, B1); PG8_BAR; PG8_SCHED;
            PG8_LDB(B0, 1, 0); PG8_LDB(B1, 1, 1); PG8_SCHED; PG8_LDA(At, 1, 0); PG8_STAGE(PG8_SA(0, 1), a2 + hstep, voffA);
            PG8_WAIT_V(8); PG8_WAIT_L(0); PG8_BAR; PG8_MMA(0, 0, At, B0); PG8_MMA(0, 1, At, B1); PG8_BAR; PG8_SCHED;
            PG8_LDA(At, 1, 1); PG8_STAGE(PG8_SB(1, 0), b3, voffB); PG8_STAGE(PG8_SB(1, 1), b3 + hstep, voffB); PG8_STAGE(PG8_SA(1, 0), a3, voffA);
            PG8_WAIT_V(8); PG8_WAIT_L(0); PG8_BAR; PG8_MMA(1, 0, At, B0); PG8_MMA(1, 1, At, B1); PG8_BAR; PG8_SCHED;
            } else {
            PG8_LDB(B0, 0, 0); PG8_SCHED; PG8_LDA(At, 0, 0); PG8_STAGE(PG8_SA(1, 1), a1 + hstep, voffA);
            PG8_WAIT_L(8); PG8_BAR; PG8_WAIT_L(0); PG8_MMA(0, 0, At, B0); PG8_BAR; PG8_SCHED;
            PG8_LDB(B1, 0, 1); PG8_STAGE(PG8_SB(0, 0), b2, voffB);
            PG8_BAR; PG8_WAIT_L(0); PG8_MMA(0, 1, At, B1); PG8_BAR;
            PG8_LDA(At, 0, 1); PG8_STAGE(PG8_SA(0, 0), a2, voffA);
            PG8_BAR; PG8_WAIT_L(0); PG8_MMA(1, 0, At, B0); PG8_BAR; PG8_SCHED;
            PG8_STAGE(PG8_SB(0, 1), b2 + hstep, voffB);
            PG8_WAIT_V(6); PG8_BAR; PG8_MMA(1, 1, At, B1); PG8_BAR;
            PG8_LDB(B0, 1, 0); PG8_SCHED; PG8_LDA(At, 1, 0); PG8_STAGE(PG8_SA(0, 1), a2 + hstep, voffA);
            PG8_WAIT_L(8); PG8_BAR; PG8_WAIT_L(0); PG8_MMA(0, 0, At, B0); PG8_BAR; PG8_SCHED;
            PG8_LDB(B1, 1, 1); PG8_STAGE(PG8_SB(1, 0), b3, voffB);
            PG8_BAR; PG8_WAIT_L(0); PG8_MMA(0, 1, At, B1); PG8_BAR;
            PG8_LDA(At, 1, 1); PG8_STAGE(PG8_SA(1, 0), a3, voffA);
            PG8_BAR; PG8_WAIT_L(0); PG8_MMA(1, 0, At, B0); PG8_BAR; PG8_SCHED;
            PG8_STAGE(PG8_SB(1, 1), b3 + hstep, voffB);
            PG8_WAIT_V(6); PG8_BAR; PG8_MMA(1, 1, At, B1); PG8_BAR;
            }
        }
        if constexpr (ALIGN_EPI) { if (wr == 0) PG8_BAR; }
        if constexpr (!Epi::AFTER_DRAIN) { E(acc, cur, wr, wc, fr, fq); S.done(cur); }
        if (!has_next) break;
#pragma unroll
        for (int a = 0; a < 2; ++a)
#pragma unroll
            for (int b = 0; b < 2; ++b)
#pragma unroll
                for (int m = 0; m < 4; ++m)
#pragma unroll
                    for (int n = 0; n < 2; ++n) acc[a][b][m][n] = (f32x4){0.f, 0.f, 0.f, 0.f};
        cur = nxt; cA = nA; cB = nB; ++ui;
        if constexpr (ALIGN_EPI) { if (wr == 1) PG8_BAR; }
    }
    PG8_WAIT_V(0);
    if constexpr (!ALIGN_EPI) { if (wr == 0) PG8_BAR; }
    PG8_BAR;
#undef PG8_SA
#undef PG8_SB
#undef PG8_STAGE
#undef PG8_LDA
#undef PG8_LDB
#undef PG8_MMA
#undef PG8_WAIT_V
#undef PG8_WAIT_L
#undef PG8_BAR
#undef PG8_SCHED
}
}

constexpr int NWAVES = 8, NTHREADS = NWAVES * 64;
constexpr int DM = 2048, DIN = 6656, DFF = 5632, DUP = 2 * DFF, DEPTH = 2;
constexpr int MG = 16384;
constexpr int RET_H = 8, NA_H = 12, DIFF_H = 6;
constexpr int C_RQ = 0, C_RK = 512, C_RV = 1024, C_RG = 1536, C_NQ = 2048, C_NK = 2816, C_NV = 3584, C_DQ = 4352, C_DK = 5120, C_DV = 5888;
constexpr int MIX_RET = 0, MIX_NA = 512, MIX_DIFF = 1280;
constexpr float NORM_EPS = 1e-6f;
constexpr float LOG2E = 1.4426950408889634f;

constexpr size_t MiB = 1u << 20;
constexpr size_t WS_CTL = 0, CTL_ZERO_BYTES = 2 * MiB;
constexpr int MT = 2 * MG;
constexpr size_t WS_WIN = 2 * MiB;
constexpr size_t WS_WUP = 54 * MiB;
constexpr size_t WS_H = 142 * MiB;
constexpr size_t WS_PROJ = 270 * MiB;
constexpr size_t WS_ACT = 686 * MiB;
constexpr size_t WS_END = 703 * MiB;
constexpr size_t OUT_MIX = 0;
constexpr size_t OUT_WOUT = 128 * MiB;
constexpr size_t OUT_WDN = 144 * MiB;
static_assert(OUT_WDN + 44 * MiB <= (size_t)MT * DM * 4 && WS_ACT + (size_t)3 * (MT / 256) * 2 * DFF * 4 <= WS_END && WS_PROJ + (size_t)MT * DIN * 2 <= WS_ACT, "workspace map");
constexpr int NBG = 96;
constexpr int CW_BAR = 4096;
constexpr int CW_QUEUE = 8192;
constexpr size_t WS_HBAR = 3 * MiB / 2;
constexpr size_t WS_SS = 65536;
static_assert(WS_SS + (size_t)2 * 5 * MG * 8 <= CTL_ZERO_BYTES && CTL_ZERO_BYTES <= WS_WIN && (CW_BAR + 3456) <= CW_QUEUE && (CW_QUEUE + 12 * 64) * 4 <= (int)WS_SS, "CTL map");

constexpr int RING_OFF = 0, RING_BYTES = 143360;
constexpr int LDSCTL_OFF = RING_BYTES, MISC_OFF = LDSCTL_OFF + 320;
constexpr int LDS_BYTES = 147456;

#define GAS __attribute__((address_space(1)))
#define LAS __attribute__((address_space(3)))
typedef unsigned short bf16;
typedef unsigned v4u __attribute__((ext_vector_type(4)));
typedef float f32x4 __attribute__((ext_vector_type(4)));
typedef GAS unsigned gu32;
#define RLX_AGENT __ATOMIC_RELAXED, __HIP_MEMORY_SCOPE_AGENT
#define LDS_WAIT() asm volatile("s_waitcnt lgkmcnt(0)" ::: "memory")
__device__ __forceinline__ unsigned f2bf(float f) { unsigned u = __builtin_bit_cast(unsigned, f); return (u + 0x7fffu + ((u >> 16) & 1u)) >> 16; }
__device__ __forceinline__ unsigned pk2(float lo, float hi) { return f2bf(lo) | (f2bf(hi) << 16); }
__device__ __forceinline__ float bflo(unsigned u) { return __uint_as_float(u << 16); }
__device__ __forceinline__ float bfhi(unsigned u) { return __uint_as_float(u & 0xffff0000u); }
__device__ __forceinline__ void unpack8(const v4u v, float* f) { f[0] = bflo(v.x); f[1] = bfhi(v.x); f[2] = bflo(v.y); f[3] = bfhi(v.y); f[4] = bflo(v.z); f[5] = bfhi(v.z); f[6] = bflo(v.w); f[7] = bfhi(v.w); }

#define XB_TMO      128
#define XB_XCNT(j)  (256  + 64 * (j))
#define XB_XSUB(j)  (1280 + 64 * (j))
#define XB_XGEN(j)  (2304 + 64 * (j))
#define XB_TOP      3328
#define XB_TOPGEN   3392
#define XCD_BAR_WORDS 3456
#define XB_SPIN_CAP (1u << 22)

__device__ __forceinline__ unsigned xb_ld(unsigned* p)              { return __hip_atomic_load(p, __ATOMIC_RELAXED, __HIP_MEMORY_SCOPE_AGENT); }
__device__ __forceinline__ unsigned xb_add(unsigned* p, unsigned v) { return __hip_atomic_fetch_add(p, v, __ATOMIC_RELAXED, __HIP_MEMORY_SCOPE_AGENT); }
__device__ __forceinline__ unsigned xb_xcc_id() { return (unsigned)__builtin_amdgcn_s_getreg((3 << 11) | 20) & 0xFu; }
#define XB_SPIN(cond, bar) do { unsigned _sp = 0; while (cond) { __builtin_amdgcn_s_sleep(1); \
    if ((++_sp & 255u) == 0u) { if (xb_ld(&(bar)[XB_TMO])) break; if (_sp > XB_SPIN_CAP) { __hip_atomic_store(&(bar)[XB_TMO], 1u, __ATOMIC_RELAXED, __HIP_MEMORY_SCOPE_AGENT); break; } } } } while (0)

struct XcdBarrier { unsigned* bar; unsigned x; volatile LAS unsigned* st; int wave; unsigned np; };

__device__ __forceinline__ XcdBarrier xcd_barrier_post(unsigned* bar, volatile LAS unsigned* st, int wave, unsigned np = 0u) {
    XcdBarrier b; b.bar = bar; b.x = xb_xcc_id(); b.st = st; b.wave = wave; b.np = np;
    if (threadIdx.x == 0) (void)xb_add(&bar[XB_XCNT(b.x)], 1u);
    return b;
}
__device__ __forceinline__ void xcd_barrier_complete(unsigned* bar, unsigned x, unsigned& nloc, unsigned& nx, unsigned np) {
    asm volatile("" : "+s"(x));
    const unsigned G = np ? np : gridDim.x * gridDim.y * gridDim.z;
    unsigned sum, cnt, mine, sp = 0u;
    for (;;) {
        sum = 0u; cnt = 0u; mine = 0u;
#pragma unroll
        for (unsigned j = 0; j < 16; ++j) { const unsigned c = xb_ld(&bar[XB_XCNT(j)]); sum += c; cnt += (c > 0u) ? 1u : 0u; mine = (j == x) ? c : mine; }
        if (sum == G) break;
        __builtin_amdgcn_s_sleep(1);
        if ((++sp & 255u) == 0u) { if (xb_ld(&bar[XB_TMO])) break; if (sp > XB_SPIN_CAP) { __hip_atomic_store(&bar[XB_TMO], 1u, __ATOMIC_RELAXED, __HIP_MEMORY_SCOPE_AGENT); break; } }
    }
    nloc = mine > 0u ? mine : 1u; nx = cnt > 0u ? cnt : 1u;
}
__device__ __forceinline__ void xcd_barrier(const XcdBarrier& b) {
    asm volatile("s_waitcnt vmcnt(0)" ::: "memory");
    __syncthreads();
    if (b.wave == 0 && lane_id_now() == 0) {
        unsigned* bar = b.bar; asm volatile("" : "+s"(bar));
        __builtin_amdgcn_s_waitcnt(0);
        unsigned nloc = b.st[0], nx = b.st[1];
        if (nloc == 0u) { xcd_barrier_complete(bar, b.x, nloc, nx, b.np); b.st[0] = nloc; b.st[1] = nx; }
        const unsigned old = xb_add(&bar[XB_XSUB(b.x)], 1u);
        const unsigned gen = old / nloc;
        if (old + 1u == (gen + 1u) * nloc) {
            __builtin_amdgcn_fence(__ATOMIC_RELEASE, "agent");
            asm volatile("s_waitcnt vmcnt(0)" ::: "memory");
            const unsigned og = xb_add(&bar[XB_TOP], 1u);
            const unsigned tg = og / nx;
            if (og + 1u == (tg + 1u) * nx) xb_add(&bar[XB_TOPGEN], 1u);
            else XB_SPIN(xb_ld(&bar[XB_TOPGEN]) == tg, bar);
            __builtin_amdgcn_fence(__ATOMIC_ACQUIRE, "agent");
            xb_add(&bar[XB_XGEN(b.x)], 1u);
            asm volatile("s_waitcnt vmcnt(0)" ::: "memory");
        } else {
            XB_SPIN(xb_ld(&bar[XB_XGEN(b.x)]) == gen, bar);
            __builtin_amdgcn_fence(__ATOMIC_ACQUIRE, "agent");
            asm volatile("s_waitcnt vmcnt(0)" ::: "memory");
        }
    }
    __syncthreads();
}

struct Frame {
    LAS unsigned char* lds;
    int tid, lane, wave;
    int G, bx;
};
__device__ __forceinline__ void frame_refresh(Frame& F) { int ln = lane_id_now();
    F.lane = ln; F.tid = F.wave * 64 + ln; }
template <int O> __device__ __forceinline__ float swz_xor(float v) { return __int_as_float(__builtin_amdgcn_ds_swizzle(__float_as_int(v), (O << 10) | 0x1f)); }
__device__ __forceinline__ void mul_inplace(float& x, float a) { asm volatile("v_mul_f32 %0, %0, %1" : "+v"(x) : "v"(a)); }
__device__ __forceinline__ int q_next(unsigned* ctr, volatile LAS int* slot, int wave, int lane) {
    __syncthreads();
    if (wave == 0 && lane == 0) *slot = (int)__hip_atomic_fetch_add(ctr, 1u, __ATOMIC_RELAXED, __HIP_MEMORY_SCOPE_AGENT);
    __syncthreads();
    return *slot;
}
__device__ __forceinline__ void store_pair16(bf16* rowp_k, int hh, unsigned ax, unsigned ay, unsigned bx, unsigned by) {
    auto r0 = __builtin_amdgcn_permlane32_swap(ax, bx, false, false); auto r1 = __builtin_amdgcn_permlane32_swap(ay, by, false, false);
    v4u w; w.x = r0[0]; w.y = r1[0]; w.z = r0[1]; w.w = r1[1];
    *(v4u*)(rowp_k + 8 * hh) = w;
}
__device__ __forceinline__ float wave_sum(float v) {
    v += swz_xor<1>(v); v += swz_xor<2>(v); v += swz_xor<4>(v); v += swz_xor<8>(v); v += swz_xor<16>(v);
    auto rr = __builtin_amdgcn_permlane32_swap(__float_as_uint(v), __float_as_uint(v), false, false);
    return __uint_as_float(rr[0]) + __uint_as_float(rr[1]);
}

template <bool UPMAP> __device__ __forceinline__ void p0_transpose_item(const float* W, int K, int N, bf16* WT, const float* gain, LAS float* scr, int item, int lane) {
    const int nblk = N / 64, kb = item / nblk, nb = item % nblk, k0 = 64 * kb, n0 = 64 * nb;
    const int lr = lane >> 4, lc = (lane & 15) * 4;
    f32x4 v[16]; float gsc[16];
#pragma unroll
    for (int i = 0; i < 16; ++i) { const int kk = 4 * i + lr; gsc[i] = gain ? gain[k0 + kk] : 1.f; v[i] = *(const GAS f32x4*)(W + (size_t)(k0 + kk) * N + n0 + lc); }
#pragma unroll
    for (int i = 0; i < 16; ++i) { const int kk = 4 * i + lr; LAS float* d = scr + kk * 65 + lc; d[0] = v[i].x * gsc[i]; d[1] = v[i].y * gsc[i]; d[2] = v[i].z * gsc[i]; d[3] = v[i].w * gsc[i]; }
    LDS_WAIT(); asm volatile("" ::: "memory");
    const int c = lane & 7;
    int r0 = n0;
    if (UPMAP) { const int isg = n0 >= DFF ? 1 : 0, chn = n0 - isg * DFF; r0 = 256 * (chn / 128) + 128 * isg + (chn % 128); }
#pragma unroll
    for (int j = 0; j < 8; ++j) { const int n = (lane >> 3) + 8 * j; const LAS float* sp = scr + (8 * c) * 65 + n;
        v4u o; o.x = pk2(sp[0 * 65], sp[1 * 65]); o.y = pk2(sp[2 * 65], sp[3 * 65]); o.z = pk2(sp[4 * 65], sp[5 * 65]); o.w = pk2(sp[6 * 65], sp[7 * 65]);
        *(GAS v4u*)(WT + (size_t)(r0 + n) * K + k0 + 8 * c) = o; }
    LDS_WAIT(); asm volatile("" ::: "memory");
}
template <bool UPMAP> __device__ __forceinline__ void transpose_matrix(Frame& F, const float* W, int K, int N, bf16* WT, const float* gain, int bx0 = 0, int nb = 0) {
    LAS float* scr = (LAS float*)(F.lds + RING_OFF + F.wave * 16640);
    const int gw = (F.bx - bx0) * NWAVES + F.wave, NGW = (nb ? nb : F.G) * NWAVES;
    const int nitems = (K / 64) * (N / 64);
    for (int it = gw; it < nitems; it += NGW) p0_transpose_item<UPMAP>(W, K, N, WT, gain, scr, it, F.lane);
}

typedef unsigned long long ssq_t;
__device__ __forceinline__ ssq_t ss_pack(float v) { const float hi = floorf(v); return ((ssq_t)(unsigned)hi << 24) + (ssq_t)(unsigned)((v - hi) * 16777216.f); }
__device__ __forceinline__ float ss_unpack(ssq_t q) { return __builtin_fmaf((float)(unsigned)(q >> 32), 256.f, (float)(unsigned)(q & 0xffffffffull) * (1.f / 16777216.f)); }
__device__ __forceinline__ void convert_rows(Frame& F, const float* xin, bf16* xb, ssq_t* ss, int nrows) {
    frame_refresh(F);
    const int gw = F.bx * NWAVES + F.wave, NGW = F.G * NWAVES;
    for (int m = gw; m < nrows; m += NGW) {
        const GAS f32x4* xr = (const GAS f32x4*)(xin + (size_t)m * DM) + F.lane;
        f32x4 v[8]; float sq = 0.f;
#pragma unroll
        for (int j = 0; j < 8; ++j) { v[j] = xr[64 * j]; sq += (v[j].x * v[j].x + v[j].y * v[j].y) + (v[j].z * v[j].z + v[j].w * v[j].w); }
        sq = wave_sum(sq);
        GAS unsigned long long* o8 = (GAS unsigned long long*)(xb + (size_t)m * DM) + F.lane;
#pragma unroll
        for (int j = 0; j < 8; ++j) o8[64 * j] = (unsigned long long)pk2(v[j].x, v[j].y) | ((unsigned long long)pk2(v[j].z, v[j].w) << 32);
        if (F.lane == 0) ss[m] = ss_pack(sq);
    }
}
__device__ __forceinline__ void final_norm_rows(Frame& F, const bf16* xb, const ssq_t* ss, const float* w, float* out, int nrows, int bx0 = 0, int nb = 0) {
    frame_refresh(F);
    const int gw = (F.bx - bx0) * NWAVES + F.wave, NGW = (nb ? nb : F.G) * NWAVES;
    for (int m = gw; m < nrows; m += NGW) {
        const float rstd = 1.f / sqrtf(ss_unpack(ss[m]) * (1.f / DM) + NORM_EPS);
#pragma unroll
        for (int j = 0; j < 4; ++j) { const int c0 = (64 * j + F.lane) * 8; float f[8]; unpack8(*(const GAS v4u*)(xb + (size_t)m * DM + c0), f);
            const f32x4 g0 = *(const GAS f32x4*)(w + c0), g1 = *(const GAS f32x4*)(w + c0 + 4);
            GAS f32x4* o = (GAS f32x4*)(out + (size_t)m * DM + c0);
            o[0] = (f32x4){f[0] * rstd * g0.x, f[1] * rstd * g0.y, f[2] * rstd * g0.z, f[3] * rstd * g0.w};
            o[1] = (f32x4){f[4] * rstd * g1.x, f[5] * rstd * g1.y, f[6] * rstd * g1.z, f[7] * rstd * g1.w}; }
    }
}

struct EpiBf16Scale {
    static constexpr bool PERM = true, AFTER_DRAIN = false;
    bf16* O; int ldc; const ssq_t* ss;
    __device__ __forceinline__ void operator()(const pg8::f32x4 (&acc)[2][2][4][2], const pg8::Unit& u, int wr, int wc, int fr, int fq) const {
        const int row0 = u.pm * 256 + wr * 64 + fr; const int col0 = u.pn * 256 + wc * 32 + 8 * fq;
#pragma unroll
        for (int ai = 0; ai < 2; ++ai)
#pragma unroll
            for (int m = 0; m < 4; ++m) { const int row = row0 + ai * 128 + m * 16; bf16* rowp = O + (size_t)row * ldc + col0;
                const float rstd = __builtin_amdgcn_rsqf(ss_unpack(ss[row]) * (1.f / DM) + NORM_EPS);
#pragma unroll
                for (int bj = 0; bj < 2; ++bj) { const pg8::f32x4 v0 = acc[ai][bj][m][0] * rstd, v1 = acc[ai][bj][m][1] * rstd;
                    v4u w; w.x = pg8::cvt_pk_bf16(v0[0], v0[1]); w.y = pg8::cvt_pk_bf16(v0[2], v0[3]); w.z = pg8::cvt_pk_bf16(v1[0], v1[1]); w.w = pg8::cvt_pk_bf16(v1[2], v1[3]);
                    *(v4u*)(rowp + bj * 128) = w; } }
    }
};
struct EpiResNorm {
    static constexpr bool PERM = true, AFTER_DRAIN = false;
    const bf16* Xin; bf16* XB; ssq_t* ss; int ldc;
    __device__ __forceinline__ void operator()(const pg8::f32x4 (&acc)[2][2][4][2], const pg8::Unit& u, int wr, int wc, int fr, int fq) const {
        const int row0 = u.pm * 256 + wr * 64 + fr; const int col0 = u.pn * 256 + wc * 32 + 8 * fq;
#pragma unroll
        for (int ai = 0; ai < 2; ++ai)
#pragma unroll
            for (int m = 0; m < 4; ++m) { const int row = row0 + ai * 128 + m * 16; const size_t off = (size_t)row * ldc + col0; float sq = 0.f;
#pragma unroll
                for (int bj = 0; bj < 2; ++bj) { pg8::f32x4 x0, x1;
                    { float f[8]; unpack8(*(const v4u*)(Xin + off + bj * 128), f); x0 = (pg8::f32x4){f[0], f[1], f[2], f[3]}; x1 = (pg8::f32x4){f[4], f[5], f[6], f[7]}; }
                    const pg8::f32x4 v0 = x0 + acc[ai][bj][m][0], v1 = x1 + acc[ai][bj][m][1];
                    v4u w; w.x = pg8::cvt_pk_bf16(v0[0], v0[1]); w.y = pg8::cvt_pk_bf16(v0[2], v0[3]); w.z = pg8::cvt_pk_bf16(v1[0], v1[1]); w.w = pg8::cvt_pk_bf16(v1[2], v1[3]);
                    *(v4u*)(XB + off + bj * 128) = w;
                    sq += (v0[0] * v0[0] + v0[1] * v0[1]) + (v0[2] * v0[2] + v0[3] * v0[3]) + (v1[0] * v1[0] + v1[1] * v1[1]) + (v1[2] * v1[2] + v1[3] * v1[3]); }
                sq += swz_xor<16>(sq); { auto rr = __builtin_amdgcn_permlane32_swap(__float_as_uint(sq), __float_as_uint(sq), false, false); sq = __uint_as_float(rr[0]) + __uint_as_float(rr[1]); }
                if (fq == 0) atomicAdd(ss + row, ss_pack(sq));
                if (m & 1) asm volatile("" ::: "memory"); }
    }
};

__device__ __forceinline__ float dpp_ror1(float v)  { return __int_as_float(__builtin_amdgcn_update_dpp(0, __float_as_int(v), 0x121, 0xf, 0xf, true)); }
__device__ __forceinline__ float dpp_ror15(float v) { return __int_as_float(__builtin_amdgcn_update_dpp(0, __float_as_int(v), 0x12f, 0xf, 0xf, true)); }
__device__ __forceinline__ float dpp_shr1(float old, float v) { return __int_as_float(__builtin_amdgcn_update_dpp(__float_as_int(old), __float_as_int(v), 0x111, 0xf, 0xf, false)); }
__device__ __forceinline__ float dpp_shl1(float old, float v) { return __int_as_float(__builtin_amdgcn_update_dpp(__float_as_int(old), __float_as_int(v), 0x101, 0xf, 0xf, false)); }
__device__ __forceinline__ float gelu_tanh_fast(float x) { const float arg = x * fmaf(x * x, -0.102943239f, -2.302208198f); return x * __builtin_amdgcn_rcpf(1.f + __builtin_amdgcn_exp2f(arg)); }
constexpr int HALO_OFF = 131072;
struct EpiUpConv {
    static constexpr bool PERM = true, AFTER_DRAIN = false;
    bf16* ACT; const ssq_t* ss; const float* cw; const float* cb; float* EP; float* EA; float* EG; LAS unsigned char* lds;
    __device__ __forceinline__ void operator()(pg8::f32x4 (&acc)[2][2][4][2], const pg8::Unit& u, int wr, int wc, int fr, int fq) const {
        const int row0 = u.pm * 256 + wr * 64 + fr; const int ch0 = u.pn * 128 + wc * 32 + 8 * fq;
        LAS float* H = (LAS float*)(lds + HALO_OFF);
#pragma unroll
        for (int ai = 0; ai < 2; ++ai)
#pragma unroll
            for (int m = 0; m < 4; ++m) { const float rstd = __builtin_amdgcn_rsqf(ss_unpack(ss[row0 + ai * 128 + m * 16]) * (1.f / DM) + NORM_EPS);
#pragma unroll
                for (int bj = 0; bj < 2; ++bj)
#pragma unroll
                    for (int n = 0; n < 2; ++n) acc[ai][bj][m][n] *= rstd; }
#pragma unroll
        for (int ai = 0; ai < 2; ++ai) { const int sl = 2 * ai + wr; LAS float* hp = H + (sl * 2) * 128 + wc * 32 + 8 * fq;
            if (fr == 0) { *(LAS pg8::f32x4*)(hp) = acc[ai][1][0][0]; *(LAS pg8::f32x4*)(hp + 4) = acc[ai][1][0][1]; }
            if (fr == 15) { *(LAS pg8::f32x4*)(hp + 128) = acc[ai][1][3][0]; *(LAS pg8::f32x4*)(hp + 128 + 4) = acc[ai][1][3][1]; } }
        asm volatile("s_waitcnt lgkmcnt(0)" ::: "memory"); __builtin_amdgcn_s_barrier(); asm volatile("" ::: "memory");
        const pg8::f32x4 zero4 = (pg8::f32x4){0.f, 0.f, 0.f, 0.f};
        pg8::f32x4 w0[2], w1[2], w2[2], bb[2];
#pragma unroll
        for (int n = 0; n < 2; ++n) { w0[n] = *(const pg8::f32x4*)(cw + ch0 + 4 * n); w1[n] = *(const pg8::f32x4*)(cw + DFF + ch0 + 4 * n); w2[n] = *(const pg8::f32x4*)(cw + 2 * DFF + ch0 + 4 * n); bb[n] = *(const pg8::f32x4*)(cb + ch0 + 4 * n); }
#pragma unroll
        for (int ai = 0; ai < 2; ++ai) { const int sl = 2 * ai + wr;
            pg8::f32x4 hu[2], hd[2];
#pragma unroll
            for (int n = 0; n < 2; ++n) { hu[n] = sl > 0 ? *(const LAS pg8::f32x4*)(H + ((sl - 1) * 2 + 1) * 128 + wc * 32 + 8 * fq + 4 * n) : zero4;
                                          hd[n] = sl < 3 ? *(const LAS pg8::f32x4*)(H + ((sl + 1) * 2) * 128 + wc * 32 + 8 * fq + 4 * n) : zero4; }
#pragma unroll
            for (int m = 0; m < 4; ++m) { const int row = row0 + ai * 128 + m * 16; float o[8]; float gcv[8];
#pragma unroll
                for (int n = 0; n < 2; ++n)
#pragma unroll
                    for (int e = 0; e < 4; ++e) { const float gv = acc[ai][1][m][n][e];
                        const float xu = (fr == 15) ? (m > 0 ? acc[ai][1][m > 0 ? m - 1 : 0][n][e] : hu[n][e]) : gv;
                        const float xd = (fr == 0) ? (m < 3 ? acc[ai][1][m < 3 ? m + 1 : 3][n][e] : hd[n][e]) : gv;
                        float gc = fmaf(w1[n][e], gv, bb[n][e]);
                        gc = fmaf(dpp_ror1(xu), w0[n][e], gc);
                        gc = fmaf(dpp_ror15(xd), w2[n][e], gc);
                        gcv[4 * n + e] = gc; }
#pragma unroll
                for (int k2 = 0; k2 < 4; ++k2) { typedef float f32x2v __attribute__((ext_vector_type(2)));
                    const f32x2v x = (f32x2v){gcv[2 * k2], gcv[2 * k2 + 1]}, av = (f32x2v){acc[ai][0][m][k2 >> 1][2 * (k2 & 1)], acc[ai][0][m][k2 >> 1][2 * (k2 & 1) + 1]};
                    const f32x2v arg = x * (x * x * (f32x2v){-0.102943239f, -0.102943239f} + (f32x2v){-2.302208198f, -2.302208198f});
                    const f32x2v dn = (f32x2v){__builtin_amdgcn_exp2f(arg.x), __builtin_amdgcn_exp2f(arg.y)} + (f32x2v){1.f, 1.f};
                    const f32x2v r = (x * av) * (f32x2v){__builtin_amdgcn_rcpf(dn.x), __builtin_amdgcn_rcpf(dn.y)};
                    o[2 * k2] = r.x; o[2 * k2 + 1] = r.y; }
                const bool etop = (sl == 0 && m == 0 && fr == 0), ebot = (sl == 3 && m == 3 && fr == 15);
                if (etop || ebot) { const size_t eo = ((size_t)u.pm * 2 + (ebot ? 1 : 0)) * DFF + ch0;
#pragma unroll
                    for (int n = 0; n < 2; ++n) { *(pg8::f32x4*)(EP + eo + 4 * n) = (pg8::f32x4){gcv[4 * n], gcv[4 * n + 1], gcv[4 * n + 2], gcv[4 * n + 3]};
                        *(pg8::f32x4*)(EA + eo + 4 * n) = acc[ai][0][m][n]; *(pg8::f32x4*)(EG + eo + 4 * n) = acc[ai][1][m][n]; }
                } else { v4u w; w.x = pg8::cvt_pk_bf16(o[0], o[1]); w.y = pg8::cvt_pk_bf16(o[2], o[3]); w.z = pg8::cvt_pk_bf16(o[4], o[5]); w.w = pg8::cvt_pk_bf16(o[6], o[7]);
                    *(v4u*)(ACT + (size_t)row * DFF + ch0) = w; }
            }
        }
    }
};
__device__ __forceinline__ void ffn_edge_fixup_panel(Frame& F, bf16* ACT, const float* EP, const float* EA, const float* EG, const float* cw, int S, int pm) {
    constexpr int NC4 = DFF / 4;
    for (int it = F.tid; it < 2 * NC4; it += NTHREADS) {
        const int c4 = (it % NC4) * 4, tbq = it / NC4;
        const int row = pm * 256 + (tbq ? 255 : 0);
        const size_t eo = ((size_t)pm * 2 + tbq) * DFF + c4;
        f32x4 gp = *(const f32x4*)(EP + eo); const f32x4 av = *(const f32x4*)(EA + eo);
        if (tbq == 0) { if (row % S != 0) { const f32x4 gn = *(const f32x4*)(EG + ((size_t)(pm - 1) * 2 + 1) * DFF + c4), w = *(const f32x4*)(cw + c4); gp = gp + gn * w; } }
        else { if ((row + 1) % S != 0) { const f32x4 gn = *(const f32x4*)(EG + ((size_t)(pm + 1) * 2) * DFF + c4), w = *(const f32x4*)(cw + 2 * DFF + c4); gp = gp + gn * w; } }
        const unsigned lo = pg8::cvt_pk_bf16(gelu_tanh_fast(gp.x) * av.x, gelu_tanh_fast(gp.y) * av.y), hi = pg8::cvt_pk_bf16(gelu_tanh_fast(gp.z) * av.z, gelu_tanh_fast(gp.w) * av.w);
        *(unsigned long long*)(ACT + (size_t)row * DFF + c4) = (unsigned long long)lo | ((unsigned long long)hi << 32);
    }
}
typedef short bf16x8 __attribute__((ext_vector_type(8)));
typedef float f32x16 __attribute__((ext_vector_type(16)));
typedef short s16x4 __attribute__((ext_vector_type(4)));
typedef short v4i16_t __attribute__((ext_vector_type(4)));
__device__ __forceinline__ unsigned cvtpk(float lo, float hi) { unsigned r; asm("v_cvt_pk_bf16_f32 %0, %1, %2" : "=v"(r) : "v"(lo), "v"(hi)); return r; }
__device__ __forceinline__ float half_max(float v) { auto rr = __builtin_amdgcn_permlane32_swap(__float_as_uint(v), __float_as_uint(v), false, false); return fmaxf(__uint_as_float(rr[0]), __uint_as_float(rr[1])); }
__device__ __forceinline__ float half_sum(float v) { auto rr = __builtin_amdgcn_permlane32_swap(__float_as_uint(v), __float_as_uint(v), false, false); return __uint_as_float(rr[0]) + __uint_as_float(rr[1]); }
#define TR_READ(dst, addr, imm) asm volatile("ds_read_b64_tr_b16 %0, %1 offset:%c2" : "=&v"(dst) : "v"(addr), "i"(imm) : "memory")
#define LGKM_WAIT(n) asm volatile("s_waitcnt lgkmcnt(" #n ")" ::: "memory")
#define VFRAG(lo, hi) ((bf16x8){(lo)[0], (lo)[1], (lo)[2], (lo)[3], (hi)[0], (hi)[1], (hi)[2], (hi)[3]})

constexpr int DF_KMAP = 8192, DF_V = 16384, DF_BUF = 32768;
constexpr int DF_Q = 2 * DF_BUF, DF_QROW = 272;
static_assert(DF_Q + 8 * 32 * DF_QROW <= RING_BYTES, "diff attention LDS");
__device__ __forceinline__ void diff_mfma(Frame& F, const bf16* proj, bf16* mix, const float* nw, float lam, float lam_init, int S, int nseq, unsigned* qctr) {
    frame_refresh(F);
    const int lane = F.lane, wave = F.wave, q32 = lane & 31, hh = lane >> 5;
    LAS unsigned char* L = F.lds + RING_OFF;
    const int nqb = S / 256, nunits = nseq * DIFF_H * nqb, NT = S / 64;
    const unsigned kaddr0 = (unsigned)(q32 * 128 + (((((q32 >> 1) & 7) >> 1) << 1 | (hh ^ ((q32 >> 1) & 1))) * 16));
    const int i16 = lane & 15, q4 = i16 >> 2, p4 = i16 & 3, g1 = (lane >> 4) & 1;
    const unsigned trlo = (unsigned)(DF_V + 64 * (4 * hh + q4) + 16 * ((2 * g1 + (p4 >> 1)) ^ hh) + 8 * (p4 & 1));
    const unsigned trhi = (unsigned)(DF_V + 2048 + 64 * (4 * hh + q4) + 16 * ((2 * g1 + (p4 >> 1)) ^ ((2 + hh) & 3)) + 8 * (p4 & 1));
    const float sc2 = 0.125f * LOG2E;
#define DF_STAGE(buf, tile) do { const bf16* k0_ = kg + (size_t)(tile) * 64 * DIN; const bf16* k1_ = k0_ + 64; const bf16* v0_ = vg + (size_t)(tile) * 64 * DIN; const bf16* v1_ = v0_ + 32 * DIN; \
        unsigned ko_ = kgoffB, vo_ = vgoffB; asm volatile("" : "+s"(k0_), "+s"(k1_), "+s"(v0_), "+s"(v1_), "+v"(ko_), "+v"(vo_)); \
        LAS unsigned char* Bw_ = L + (buf) * DF_BUF + wave * 1024; \
        __builtin_amdgcn_global_load_lds((const unsigned*)((const char*)k0_ + ko_), (LAS unsigned*)(Bw_), 16, 0, 0); \
        __builtin_amdgcn_global_load_lds((const unsigned*)((const char*)k1_ + ko_), (LAS unsigned*)(Bw_ + DF_KMAP), 16, 0, 0); \
        __builtin_amdgcn_global_load_lds((const unsigned*)((const char*)v0_ + vo_), (LAS unsigned*)(Bw_ + DF_V), 16, 0, 0); \
        __builtin_amdgcn_global_load_lds((const unsigned*)((const char*)v1_ + vo_), (LAS unsigned*)(Bw_ + DF_V + 8192), 16, 0, 0); } while (0)
    for (;;) {
        const int lane_u = lane_id_now();
        const int it = q_next(qctr, (volatile LAS int*)(F.lds + MISC_OFF + 64), wave, lane_u); if (it >= nunits) break;
        const int qb = it % nqb, h = (it / nqb) % DIFF_H, s = it / (nqb * DIFF_H);
        const int row0 = s * S;
        const float nslope2 = __uint_as_float(__builtin_amdgcn_readfirstlane(__float_as_uint(-exp2f(-8.f * (float)(h + 1) / 6.f) * LOG2E)));
        const int ih = qb * 256 + wave * 32 + (lane_u & 31) - 4 * (lane_u >> 5);
        const int td = (qb * 256 + wave * 32) >> 6;
        const int kkey = 8 * wave + (lane_u >> 3);
        const unsigned kgoffB = (unsigned)(kkey * DIN + ((lane_u & 7) ^ ((kkey >> 1) & 7)) * 8) * 2u;
        unsigned vgoffB;
        { const int pv = wave, rowhi = pv >> 1, chhi = 2 * (pv & 1) + (lane_u >> 5), r7 = (lane_u & 31) >> 2, slot = lane_u & 3;
          const int x = (2 * (rowhi & 1) + (r7 >> 2)) & 3, ch = 4 * chhi + (slot ^ x), row = 8 * rowhi + r7; vgoffB = (unsigned)(row * DIN + ch * 8) * 2u; }
        const bf16* kg = proj + (size_t)row0 * DIN + C_DK + h * 128;
        const bf16* vg = proj + (size_t)row0 * DIN + C_DV + h * 128;
        DF_STAGE(0, 0);
        bf16x8 qf[2][4];
        { const bf16* qp = proj + (size_t)(row0 + qb * 256 + wave * 32 + (lane_u & 31)) * DIN + C_DQ + h * 128 + (lane_u >> 5) * 8;
#pragma unroll
          for (int c = 0; c < 2; ++c)
#pragma unroll
              for (int ds = 0; ds < 4; ++ds) { float f[8]; unpack8(*(const v4u*)(qp + c * 64 + ds * 16), f);
                  v4u w; w.x = cvtpk(f[0] * sc2, f[1] * sc2); w.y = cvtpk(f[2] * sc2, f[3] * sc2); w.z = cvtpk(f[4] * sc2, f[5] * sc2); w.w = cvtpk(f[6] * sc2, f[7] * sc2);
                  qf[c][ds] = __builtin_bit_cast(bf16x8, w); } }
        const unsigned tra_lo = (unsigned)(uintptr_t)L + trlo, tra_hi = (unsigned)(uintptr_t)L + trhi;
        f32x16 O[2][4];
#pragma unroll
        for (int c = 0; c < 2; ++c)
#pragma unroll
            for (int db = 0; db < 4; ++db)
#pragma unroll
                for (int r = 0; r < 16; ++r) O[c][db][r] = 0.f;
        float m = 0.f, l[2] = {0.f, 0.f};
        asm volatile("s_waitcnt vmcnt(0)" ::: "memory");
        __syncthreads();
#pragma unroll 1
        for (int t2 = 0; t2 < NT; t2 += 2) {
#pragma unroll
          for (int tb_ = 0; tb_ < 2; ++tb_) {
            const int t = t2 + tb_;
            const LAS unsigned char* B = L + tb_ * DF_BUF;
            if (t + 1 < NT) DF_STAGE(tb_ ^ 1, t + 1);
            const float nsS = __uint_as_float(__builtin_amdgcn_readfirstlane(__float_as_uint(t < td ? nslope2 : -nslope2)));
            const float ns8 = __uint_as_float(__builtin_amdgcn_readfirstlane(__float_as_uint(8.f * nsS)));
#pragma unroll
            for (int kb = 0; kb < 2; ++kb) {
                bf16x8 kf[2][4];
#pragma unroll
                for (int c = 0; c < 2; ++c)
#pragma unroll
                    for (int ds = 0; ds < 4; ++ds) kf[c][ds] = *(const LAS bf16x8*)(B + c * DF_KMAP + kb * 4096 + (kaddr0 ^ (unsigned)(ds << 5)));
                __builtin_amdgcn_sched_barrier(0);
                f32x16 bias;
                float tbk = (float)(ih - t * 64 - 32 * kb); asm volatile("" : "+v"(tbk));
                if (__builtin_expect(t != td, 1)) {
                    const float b0 = __builtin_fmaf(tbk, nsS, -m);
                    bias[0] = b0; bias[4] = b0 - ns8; bias[8] = __builtin_fmaf(-2.f, ns8, b0); bias[12] = bias[8] - ns8;
#pragma unroll
                    for (int j = 0; j < 4; ++j) { bias[4 * j + 1] = bias[4 * j] - nsS; bias[4 * j + 2] = __builtin_fmaf(-2.f, nsS, bias[4 * j]); bias[4 * j + 3] = __builtin_fmaf(-2.f, nsS, bias[4 * j + 1]); }
                } else {
#pragma unroll
                    for (int r = 0; r < 16; ++r) bias[r] = __builtin_fmaf(__builtin_fabsf(tbk - (float)((r & 3) + 8 * (r >> 2))), nslope2, -m);
                }
                __builtin_amdgcn_sched_barrier(0);
                f32x16 a[2];
#pragma unroll
                for (int c = 0; c < 2; ++c)
#pragma unroll
                    for (int ds = 0; ds < 4; ++ds) a[c] = __builtin_amdgcn_mfma_f32_32x32x16_bf16(kf[c][ds], qf[c][ds], ds == 0 ? bias : a[c], 0, 0, 0);
                s16x4 vl[4][2], vh[4][2];
#define DF_VREQ(db) do { _Pragma("unroll") for (int sI = 0; sI < 2; ++sI) { TR_READ(vl[db][sI], tra_lo, tb_ * DF_BUF + 4096 * (2 * kb + sI) + 512 * (db)); TR_READ(vh[db][sI], tra_hi, tb_ * DF_BUF + 4096 * (2 * kb + sI) + 512 * (db)); } } while (0)
#define DF_PV(db) do { _Pragma("unroll") for (int sI = 0; sI < 2; ++sI) { const bf16x8 vf = VFRAG(vl[db][sI], vh[db][sI]); \
                        O[0][db] = __builtin_amdgcn_mfma_f32_32x32x16_bf16(vf, pf[0][sI], O[0][db], 0, 0, 0); O[1][db] = __builtin_amdgcn_mfma_f32_32x32x16_bf16(vf, pf[1][sI], O[1][db], 0, 0, 0); } } while (0)
                __builtin_amdgcn_sched_barrier(0);
                DF_VREQ(0); DF_VREQ(1);
                bf16x8 pf[2][2];
                float ls[2] = {0.f, 0.f};
#pragma unroll
                for (int c = 0; c < 2; ++c)
#pragma unroll
                    for (int r = 0; r < 16; ++r) { const float p = __builtin_amdgcn_exp2f(a[c][r]); ls[c] += p; a[c][r] = p; }
                if (__builtin_expect(__any(fmaxf(ls[0], ls[1]) > 65536.f), 0)) {
                    const float lm = fmaxf(ls[0], ls[1]);
                    const int e_ = __builtin_amdgcn_frexp_expf(lm) - 1; const float dl = half_max((float)(e_ > 0 ? e_ : 0)), alpha = __builtin_amdgcn_exp2f(-dl);
                    m += dl;
#pragma unroll
                    for (int c = 0; c < 2; ++c) { l[c] *= alpha; ls[c] *= alpha;
#pragma unroll
                        for (int r = 0; r < 16; ++r) { float x_ = a[c][r]; mul_inplace(x_, alpha); a[c][r] = x_; }
#pragma unroll
                        for (int db = 0; db < 4; ++db)
#pragma unroll
                            for (int r = 0; r < 16; ++r) { float x_ = O[c][db][r]; mul_inplace(x_, alpha); O[c][db][r] = x_; } } }
#pragma unroll
                for (int c = 0; c < 2; ++c) { l[c] += ls[c];
#pragma unroll
                    for (int sI = 0; sI < 2; ++sI) { v4u w; w.x = cvtpk(a[c][8 * sI], a[c][8 * sI + 1]); w.y = cvtpk(a[c][8 * sI + 2], a[c][8 * sI + 3]); w.z = cvtpk(a[c][8 * sI + 4], a[c][8 * sI + 5]); w.w = cvtpk(a[c][8 * sI + 6], a[c][8 * sI + 7]);
                        pf[c][sI] = __builtin_bit_cast(bf16x8, w); }
                }
                __builtin_amdgcn_sched_barrier(0);
                LGKM_WAIT(4); __builtin_amdgcn_sched_barrier(0);
                DF_VREQ(2); __builtin_amdgcn_sched_barrier(0);
                DF_PV(0);   __builtin_amdgcn_sched_barrier(0);
                LGKM_WAIT(4); __builtin_amdgcn_sched_barrier(0);
                DF_VREQ(3); __builtin_amdgcn_sched_barrier(0);
                DF_PV(1);   __builtin_amdgcn_sched_barrier(0);
                LGKM_WAIT(4); __builtin_amdgcn_sched_barrier(0);
                DF_PV(2);   __builtin_amdgcn_sched_barrier(0);
                LGKM_WAIT(0); __builtin_amdgcn_sched_barrier(0);
                DF_PV(3);   __builtin_amdgcn_sched_barrier(0);
#undef DF_VREQ
#undef DF_PV
            }
            asm volatile("s_waitcnt vmcnt(0) lgkmcnt(0)" ::: "memory");
            __builtin_amdgcn_s_barrier(); asm volatile("" ::: "memory");
          }
        }
        const float inv0 = 1.f / half_sum(l[0]), inv1 = lam / half_sum(l[1]);
        float ss = 0.f;
#pragma unroll
        for (int db = 0; db < 4; ++db)
#pragma unroll
            for (int r = 0; r < 16; ++r) { const float o = O[0][db][r] * inv0 - O[1][db][r] * inv1; O[0][db][r] = o; ss += o * o; }
        ss = half_sum(ss);
        float li_ = __uint_as_float(__builtin_amdgcn_readfirstlane(__float_as_uint(lam_init))); asm volatile("" : "+s"(li_));
        const float rn = (1.f - li_) / sqrtf(ss * (1.f / 128.f) + NORM_EPS);
        const int lane_e = lane_id_now();
        const int hh_u = lane_e >> 5, i_u = qb * 256 + wave * 32 + (lane_e & 31);
        bf16* op = mix + (size_t)(row0 + i_u) * DM + MIX_DIFF + h * 128; const float* wp = nw + h * 128 + 4 * hh_u;
#pragma unroll
        for (int db = 0; db < 4; ++db)
#pragma unroll
            for (int rp = 0; rp < 2; ++rp) { unsigned w[2][2];
#pragma unroll
                for (int q_ = 0; q_ < 2; ++q_) { const int rg = 2 * rp + q_; const f32x4 g = *(const f32x4*)(wp + 32 * db + 8 * rg);
                    w[q_][0] = cvtpk(O[0][db][4 * rg] * rn * g.x, O[0][db][4 * rg + 1] * rn * g.y); w[q_][1] = cvtpk(O[0][db][4 * rg + 2] * rn * g.z, O[0][db][4 * rg + 3] * rn * g.w); }
                store_pair16(op + 32 * db + 16 * rp, hh_u, w[0][0], w[0][1], w[1][0], w[1][1]); }
    }
#undef DF_STAGE
}

constexpr int RT_V = 8192, RT_BUF = 16384, RT_NBUF = 4, RT_Q = RT_NBUF * RT_BUF, RT_QROW = 144;
constexpr int RT_SX = RT_Q + 8 * 32 * RT_QROW;
static_assert(RT_SX + 16384 + 64 * 144 <= RING_BYTES, "retention LDS");
__device__ __forceinline__ void ret_mfma(Frame& F, const bf16* proj, bf16* mix, const float* dec_f, const float* dec_b, const float* nw, int S, int nseq, unsigned* qctr) {
    frame_refresh(F);
    const int lane = F.lane, wave = F.wave, q32 = lane & 31, hh = lane >> 5;
    LAS unsigned char* L = F.lds + RING_OFF;
    const int nqb = S / 256, nunits = nseq * RET_H * nqb, NT = S / 64;
    const int kkey = 8 * wave + (lane >> 3);
    const unsigned kgoff = (unsigned)(kkey * DIN + ((lane & 7) ^ ((kkey >> 1) & 7)) * 8);
    unsigned vgoff;
    { const int chq = lane >> 5, r7 = (lane & 31) >> 2, slot = lane & 3, x = (2 * (wave & 1) + (r7 >> 2)) & 3; vgoff = (unsigned)((8 * wave + r7) * DIN + (4 * chq + (slot ^ x)) * 8); }
    const unsigned kaddr0 = (unsigned)(q32 * 128 + (((((q32 >> 1) & 7) >> 1) << 1 | (hh ^ ((q32 >> 1) & 1))) * 16));
    const int i16 = lane & 15, q4 = i16 >> 2, p4 = i16 & 3, g1 = (lane >> 4) & 1;
    const unsigned trlo = (unsigned)(RT_V + 64 * (4 * hh + q4) + 16 * ((2 * g1 + (p4 >> 1)) ^ hh) + 8 * (p4 & 1));
    const unsigned trhi = (unsigned)(RT_V + 1024 + 64 * (4 * hh + q4) + 16 * ((2 * g1 + (p4 >> 1)) ^ ((2 + hh) & 3)) + 8 * (p4 & 1));
#define RT_STAGE(buf, tile) do { const size_t go_ = (size_t)(tile) * 64 * DIN; LAS unsigned char* Bw_ = L + (buf) * RT_BUF + wave * 1024; \
        __builtin_amdgcn_global_load_lds((const unsigned*)(kg + go_ + kgoff), (LAS unsigned*)(Bw_), 16, 0, 0); \
        __builtin_amdgcn_global_load_lds((const unsigned*)(vg + go_ + vgoff), (LAS unsigned*)(Bw_ + RT_V), 16, 0, 0); } while (0)
    for (;;) {
        const int it = q_next(qctr, (volatile LAS int*)(F.lds + MISC_OFF + 64), wave, lane); if (it >= nunits) break;
        const int qb = it % nqb, h = (it / nqb) % RET_H, s = it / (nqb * RET_H);
        const int row0 = s * S, i = qb * 256 + wave * 32 + q32;
        const float lgf = __uint_as_float(__builtin_amdgcn_readfirstlane(__float_as_uint(-log2f(1.f + expf(-dec_f[h])))));
        const float lgb = __uint_as_float(__builtin_amdgcn_readfirstlane(__float_as_uint(-log2f(1.f + expf(-dec_b[h])))));
        int lane_u = lane; asm volatile("" : "+v"(lane_u));
        const bf16* kg = proj + (size_t)row0 * DIN + C_RK + h * 64;
        const bf16* vg = proj + (size_t)row0 * DIN + C_RV + h * 64;
        { const int nL_ = 4 * qb; const int t0 = (0 < nL_ + 4 ? 0 : NT - 1 - (0 - nL_ - 4)), t1 = (1 < nL_ + 4 ? 1 : NT - 1 - (1 - nL_ - 4)), t2 = (2 < nL_ + 4 ? 2 : NT - 1 - (2 - nL_ - 4));
          RT_STAGE(0, t0); RT_STAGE(1, t1); RT_STAGE(2, t2); }
        { LAS unsigned char* Qw = L + RT_Q + wave * (32 * RT_QROW);
#pragma unroll
          for (int k = 0; k < 4; ++k) { const int idx = k * 64 + lane_u, qrow = idx >> 3, qch = idx & 7; float f[8];
              unpack8(*(const v4u*)(proj + (size_t)(row0 + qb * 256 + wave * 32 + qrow) * DIN + C_RQ + h * 64 + qch * 8), f);
              v4u w; w.x = cvtpk(f[0] * 0.125f, f[1] * 0.125f); w.y = cvtpk(f[2] * 0.125f, f[3] * 0.125f); w.z = cvtpk(f[4] * 0.125f, f[5] * 0.125f); w.w = cvtpk(f[6] * 0.125f, f[7] * 0.125f);
              *(LAS v4u*)(Qw + qrow * RT_QROW + qch * 16) = w; } }
        const LAS unsigned char* Qr = L + RT_Q + wave * (32 * RT_QROW) + q32 * RT_QROW + hh * 16;
        const unsigned tra_lo = (unsigned)(uintptr_t)L + trlo, tra_hi = (unsigned)(uintptr_t)L + trhi;
        const int nL = 4 * qb, nSteps = NT;
#define RT_TILE_OF(st) ((st) < nL + 4 ? (st) : (NT - 1 - ((st) - nL - 4)))
        f32x16 O[2], St;
#pragma unroll
        for (int r = 0; r < 16; ++r) { O[0][r] = 0.f; O[1][r] = 0.f; St[r] = 0.f; }
        int lx = lane_u; asm volatile("" : "+v"(lx));
        const int hhx = lx >> 5, q4x = (lx & 15) >> 2, p4x = lx & 3, g1x = (lx >> 4) & 1;
        const int bd = wave & 1, be = (wave >> 1) & 1, kh = wave >> 2;
        const unsigned ka_lo = (unsigned)(uintptr_t)L + (unsigned)((4 * hhx + q4x) * 128 + (((4 * bd + 2 * g1x + (p4x >> 1)) ^ ((2 * hhx + (q4x >> 1)) & 7)) * 16) + 8 * (p4x & 1));
        const unsigned ka_hi = (unsigned)(uintptr_t)L + (unsigned)((8 + 4 * hhx + q4x) * 128 + (((4 * bd + 2 * g1x + (p4x >> 1)) ^ ((4 + 2 * hhx + (q4x >> 1)) & 7)) * 16) + 8 * (p4x & 1));
        float kfs[2][8];
#pragma unroll
        for (int sx = 0; sx < 2; ++sx)
#pragma unroll
            for (int j = 0; j < 8; ++j) kfs[sx][j] = __builtin_amdgcn_exp2f(lgf * (float)(63 - (16 * (2 * kh + sx) + (j < 4 ? 4 * hhx + j : 8 + 4 * hhx + (j - 4)))));
        const float gf64 = __builtin_amdgcn_exp2f(lgf * 64.f), gb64 = __builtin_amdgcn_exp2f(lgb * 64.f);
        const int iloc = wave * 32 + (lx & 31);
        LAS float* SXF = (LAS float*)(L + RT_SX);
        LAS unsigned char* SXB = L + RT_SX + 16384;
#define RT_SIDE_DONE(rowfac) do { \
            asm volatile("s_waitcnt lgkmcnt(0)" ::: "memory"); __builtin_amdgcn_s_barrier(); asm volatile("" ::: "memory"); \
            if (kh == 1) { _Pragma("unroll") for (int r = 0; r < 16; ++r) SXF[((wave & 3) * 16 + r) * 64 + lx] = St[r]; } \
            asm volatile("s_waitcnt lgkmcnt(0)" ::: "memory"); __builtin_amdgcn_s_barrier(); asm volatile("" ::: "memory"); \
            if (kh == 0) { _Pragma("unroll") for (int rg = 0; rg < 4; ++rg) { float v_[4]; \
                    _Pragma("unroll") for (int e_ = 0; e_ < 4; ++e_) v_[e_] = St[4 * rg + e_] + SXF[((wave & 3) * 16 + 4 * rg + e_) * 64 + lx]; \
                    *(LAS unsigned long long*)(SXB + (32 * be + (lx & 31)) * 144 + (32 * bd + 8 * rg + 4 * hhx) * 2) = (unsigned long long)cvtpk(v_[0], v_[1]) | ((unsigned long long)cvtpk(v_[2], v_[3]) << 32); } } \
            asm volatile("s_waitcnt lgkmcnt(0)" ::: "memory"); __builtin_amdgcn_s_barrier(); asm volatile("" ::: "memory"); \
            { f32x16 x0, x1; _Pragma("unroll") for (int r = 0; r < 16; ++r) { x0[r] = 0.f; x1[r] = 0.f; } \
              _Pragma("unroll") for (int ds = 0; ds < 4; ++ds) { const bf16x8 qv = *(const LAS bf16x8*)(Qr + ds * 32); \
                  const bf16x8 s0 = *(const LAS bf16x8*)(SXB + (lx & 31) * 144 + ds * 32 + hhx * 16), s1 = *(const LAS bf16x8*)(SXB + (32 + (lx & 31)) * 144 + ds * 32 + hhx * 16); \
                  x0 = __builtin_amdgcn_mfma_f32_32x32x16_bf16(s0, qv, x0, 0, 0, 0); x1 = __builtin_amdgcn_mfma_f32_32x32x16_bf16(s1, qv, x1, 0, 0, 0); } \
              const float rf_ = (rowfac); _Pragma("unroll") for (int r = 0; r < 16; ++r) { O[0][r] += x0[r] * rf_; O[1][r] += x1[r] * rf_; St[r] = 0.f; } } \
        } while (0)
#pragma unroll 1
        for (int st = 0; st < nSteps; ++st) {
            const int t = RT_TILE_OF(st);
            const unsigned boff = (unsigned)((st & 3) * RT_BUF);
            const LAS unsigned char* B = L + boff;
            const unsigned tl = tra_lo + boff, th = tra_hi + boff;
            if (st + 2 < nSteps) asm volatile("s_waitcnt vmcnt(4)" ::: "memory"); else if (st + 1 < nSteps) asm volatile("s_waitcnt vmcnt(2)" ::: "memory"); else asm volatile("s_waitcnt vmcnt(0)" ::: "memory");
            __builtin_amdgcn_s_barrier(); asm volatile("" ::: "memory");
            if (st + 3 < nSteps) { const int tn = RT_TILE_OF(st + 3); RT_STAGE((st + 3) & 3, tn); }
            const bool diag = (st >= nL) && (st < nL + 4);
            if (st == nL) {
                RT_SIDE_DONE(__builtin_amdgcn_exp2f(lgf * (float)(iloc + 1)));
#pragma unroll
                for (int sx = 0; sx < 2; ++sx)
#pragma unroll
                    for (int j = 0; j < 8; ++j) kfs[sx][j] = __builtin_amdgcn_exp2f(lgb * (float)(16 * (2 * kh + sx) + (j < 4 ? 4 * hhx + j : 8 + 4 * hhx + (j - 4))));
            }
            if (!diag) {
                const float g64 = st < nL ? gf64 : gb64;
#pragma unroll
                for (int r = 0; r < 16; ++r) St[r] *= g64;
                s16x4 kl[2], khh[2], vl2[2], vh2[2];
                const unsigned kal = ka_lo + boff, kah = ka_hi + boff, tlb = tl + 512u * (unsigned)be, thb = th + 512u * (unsigned)be;
#pragma unroll
                for (int sx = 0; sx < 2; ++sx) { if (kh == 0) { TR_READ(kl[sx], kal, 2048 * sx); TR_READ(khh[sx], kah, 2048 * sx); TR_READ(vl2[sx], tlb, 2048 * sx); TR_READ(vh2[sx], thb, 2048 * sx); }
                                                 else         { TR_READ(kl[sx], kal, 2048 * (2 + sx)); TR_READ(khh[sx], kah, 2048 * (2 + sx)); TR_READ(vl2[sx], tlb, 2048 * (2 + sx)); TR_READ(vh2[sx], thb, 2048 * (2 + sx)); } }
                LGKM_WAIT(0); __builtin_amdgcn_sched_barrier(0);
#pragma unroll
                for (int sx = 0; sx < 2; ++sx) {
                    unsigned kw[4];
#pragma unroll
                    for (int d2 = 0; d2 < 2; ++d2) { const unsigned ulo = ((unsigned)(unsigned short)kl[sx][2 * d2]) | ((unsigned)(unsigned short)kl[sx][2 * d2 + 1] << 16), uhi = ((unsigned)(unsigned short)khh[sx][2 * d2]) | ((unsigned)(unsigned short)khh[sx][2 * d2 + 1] << 16);
                        kw[d2] = cvtpk(bflo(ulo) * kfs[sx][2 * d2], bfhi(ulo) * kfs[sx][2 * d2 + 1]); kw[2 + d2] = cvtpk(bflo(uhi) * kfs[sx][4 + 2 * d2], bfhi(uhi) * kfs[sx][4 + 2 * d2 + 1]); }
                    const bf16x8 af = __builtin_bit_cast(bf16x8, (v4u){kw[0], kw[1], kw[2], kw[3]});
                    St = __builtin_amdgcn_mfma_f32_32x32x16_bf16(af, VFRAG(vl2[sx], vh2[sx]), St, 0, 0, 0); }
            } else {
            const float tb = (float)(i - t * 64 - 4 * hh);
            {
                f32x16 a0, a1;
#pragma unroll
                for (int r = 0; r < 16; ++r) { a0[r] = 0.f; a1[r] = 0.f; }
#pragma unroll
                for (int ds = 0; ds < 4; ++ds) { const bf16x8 qv = *(const LAS bf16x8*)(Qr + ds * 32);
                    const bf16x8 k0 = *(const LAS bf16x8*)(B + (kaddr0 ^ (unsigned)(ds << 5))), k1 = *(const LAS bf16x8*)(B + 4096 + (kaddr0 ^ (unsigned)(ds << 5)));
                    a0 = __builtin_amdgcn_mfma_f32_32x32x16_bf16(k0, qv, a0, 0, 0, 0); a1 = __builtin_amdgcn_mfma_f32_32x32x16_bf16(k1, qv, a1, 0, 0, 0); }
                s16x4 vl[2][4], vh[2][4];
                __builtin_amdgcn_sched_barrier(0);
#pragma unroll
                for (int db = 0; db < 2; ++db)
#pragma unroll
                    for (int ks = 0; ks < 4; ++ks) { TR_READ(vl[db][ks], tl, 2048 * ks + 512 * db); TR_READ(vh[db][ks], th, 2048 * ks + 512 * db); }
                __builtin_amdgcn_sched_barrier(0);
#pragma unroll
                for (int r = 0; r < 16; ++r) { const float t0 = tb - (float)((r & 3) + 8 * (r >> 2)), t1 = t0 - 32.f;
                    a0[r] *= __builtin_amdgcn_exp2f(fabsf(t0) * (t0 >= 0.f ? lgf : lgb)); a1[r] *= __builtin_amdgcn_exp2f(fabsf(t1) * (t1 >= 0.f ? lgf : lgb)); }
                bf16x8 pf[4];
#pragma unroll
                for (int sI = 0; sI < 2; ++sI) { v4u w; w.x = cvtpk(a0[8 * sI], a0[8 * sI + 1]); w.y = cvtpk(a0[8 * sI + 2], a0[8 * sI + 3]); w.z = cvtpk(a0[8 * sI + 4], a0[8 * sI + 5]); w.w = cvtpk(a0[8 * sI + 6], a0[8 * sI + 7]);
                    pf[sI] = __builtin_bit_cast(bf16x8, w);
                    v4u x; x.x = cvtpk(a1[8 * sI], a1[8 * sI + 1]); x.y = cvtpk(a1[8 * sI + 2], a1[8 * sI + 3]); x.z = cvtpk(a1[8 * sI + 4], a1[8 * sI + 5]); x.w = cvtpk(a1[8 * sI + 6], a1[8 * sI + 7]);
                    pf[2 + sI] = __builtin_bit_cast(bf16x8, x); }
                __builtin_amdgcn_sched_barrier(0); LGKM_WAIT(0); __builtin_amdgcn_sched_barrier(0);
#pragma unroll
                for (int ks = 0; ks < 4; ++ks)
#pragma unroll
                    for (int db = 0; db < 2; ++db) O[db] = __builtin_amdgcn_mfma_f32_32x32x16_bf16(VFRAG(vl[db][ks], vh[db][ks]), pf[ks], O[db], 0, 0, 0);
            }
            }
            asm volatile("s_waitcnt lgkmcnt(0)" ::: "memory");
        }
        RT_SIDE_DONE(__builtin_amdgcn_exp2f(lgb * (float)(256 - iloc)));
#undef RT_SIDE_DONE
#undef RT_TILE_OF
        float sm = 0.f;
#pragma unroll
        for (int db = 0; db < 2; ++db)
#pragma unroll
            for (int r = 0; r < 16; ++r) sm += O[db][r];
        const float mean = half_sum(sm) * (1.f / 64.f); float var = 0.f;
#pragma unroll
        for (int db = 0; db < 2; ++db)
#pragma unroll
            for (int r = 0; r < 16; ++r) { O[db][r] -= mean; var += O[db][r] * O[db][r]; }
        const float rstd = 1.f / sqrtf(half_sum(var) * (1.f / 64.f) + NORM_EPS);
        const int hh_u = lane_u >> 5, i_u = qb * 256 + wave * 32 + (lane_u & 31);
        const bf16* gp = proj + (size_t)(row0 + i_u) * DIN + C_RG + h * 64 + 4 * hh_u; bf16* op = mix + (size_t)(row0 + i_u) * DM + MIX_RET + h * 64; const float* wp = nw + h * 64 + 4 * hh_u;
#pragma unroll
        for (int db = 0; db < 2; ++db)
#pragma unroll
            for (int rp = 0; rp < 2; ++rp) { unsigned w[2][2];
#pragma unroll
              for (int q_ = 0; q_ < 2; ++q_) { const int rg = 2 * rp + q_; const f32x4 gw = *(const f32x4*)(wp + 32 * db + 8 * rg); const unsigned long long gv = *(const unsigned long long*)(gp + 32 * db + 8 * rg);
                const float g0 = bflo((unsigned)gv), g1_ = bfhi((unsigned)gv), g2 = bflo((unsigned)(gv >> 32)), g3 = bfhi((unsigned)(gv >> 32));
                const float y0 = O[db][4 * rg] * rstd * gw.x * (g0 / (1.f + __expf(-g0))), y1 = O[db][4 * rg + 1] * rstd * gw.y * (g1_ / (1.f + __expf(-g1_)));
                const float y2 = O[db][4 * rg + 2] * rstd * gw.z * (g2 / (1.f + __expf(-g2))), y3 = O[db][4 * rg + 3] * rstd * gw.w * (g3 / (1.f + __expf(-g3)));
                w[q_][0] = cvtpk(y0, y1); w[q_][1] = cvtpk(y2, y3); }
              store_pair16(op + 32 * db + 16 * rp, hh_u, w[0][0], w[0][1], w[1][0], w[1][1]); }
    }
#undef RT_STAGE
}

constexpr int NA_TBL = RT_Q + 8 * 32 * RT_QROW, NA_TROW = 160;
static_assert(NA_TBL + 15 * NA_TROW * 4 <= RING_BYTES, "NA LDS");
__device__ __forceinline__ void na_mfma(Frame& F, const bf16* proj, bf16* mix, const float* rpb, int S, int nseq, unsigned* qctr) {
    frame_refresh(F);
    const int lane = F.lane, wave = F.wave, q32 = lane & 31, hh = lane >> 5;
    LAS unsigned char* L = F.lds + RING_OFF;
    const int rows = S / 64, nrq = rows / 4, nunits = nseq * NA_H * nrq;
    const int kkey = 8 * wave + (lane >> 3);
    const unsigned kgoff = (unsigned)(kkey * DIN + ((lane & 7) ^ ((kkey >> 1) & 7)) * 8);
    unsigned vgoff;
    { const int chq = lane >> 5, r7 = (lane & 31) >> 2, slot = lane & 3, x = (2 * (wave & 1) + (r7 >> 2)) & 3; vgoff = (unsigned)((8 * wave + r7) * DIN + (4 * chq + (slot ^ x)) * 8); }
    const int blk = wave & 3, rp = wave >> 2, qc = 16 * blk + (q32 & 15);
    const int cb = (16 * blk - 8) < 0 ? 0 : ((16 * blk - 8) > 32 ? 32 : (16 * blk - 8));
    const int cs = (qc - 8) < 0 ? 0 : ((qc - 8) > 48 ? 48 : (qc - 8));
    const int kcol = cb + q32;
    const unsigned kaddr0 = (unsigned)(kcol * 128 + (((((kcol >> 1) & 7) >> 1) << 1 | (hh ^ ((kcol >> 1) & 1))) * 16));
    const int i16 = lane & 15, q4 = i16 >> 2, p4 = i16 & 3, g1 = (lane >> 4) & 1, pc0 = cb >> 3;
    const unsigned trlo = (unsigned)(RT_V + pc0 * 1024 + 64 * (4 * hh + q4) + 16 * ((2 * g1 + (p4 >> 1)) ^ ((2 * (pc0 & 1) + hh) & 3)) + 8 * (p4 & 1));
    const unsigned trhi = (unsigned)(RT_V + (pc0 + 1) * 1024 + 64 * (4 * hh + q4) + 16 * ((2 * g1 + (p4 >> 1)) ^ ((2 * ((pc0 + 1) & 1) + hh) & 3)) + 8 * (p4 & 1));
    const int vbase = cb + 4 * hh - cs;
    const unsigned tbase = (unsigned)(NA_TBL + (64 + 15 + cb + 4 * hh - qc) * 4);
    const float qsc = 0.125f * LOG2E;
#define NA_STAGE(buf, krow) do { const size_t go_ = (size_t)(krow) * 64 * DIN; LAS unsigned char* Bw_ = L + (buf) * RT_BUF + wave * 1024; \
        __builtin_amdgcn_global_load_lds((const unsigned*)(kg + go_ + kgoff), (LAS unsigned*)(Bw_), 16, 0, 0); \
        __builtin_amdgcn_global_load_lds((const unsigned*)(vg + go_ + vgoff), (LAS unsigned*)(Bw_ + RT_V), 16, 0, 0); } while (0)
    for (;;) {
        const int it = q_next(qctr, (volatile LAS int*)(F.lds + MISC_OFF + 64), wave, lane); if (it >= nunits) break;
        const int rq = it % nrq, h = (it / nrq) % NA_H, s = it / (nrq * NA_H);
        const int row0 = s * S;
        int lane_u = lane; asm volatile("" : "+v"(lane_u));
        const int r = 4 * rq + 2 * rp + ((lane_u & 31) >> 4);
        int rs = r - 4; rs = rs < 0 ? 0 : (rs > rows - 8 ? rows - 8 : rs);
        int rw0 = 4 * rq + 2 * rp - 4; rw0 = rw0 < 0 ? 0 : (rw0 > rows - 8 ? rows - 8 : rw0);
        int rw1 = 4 * rq + 2 * rp - 3; rw1 = rw1 < 0 ? 0 : (rw1 > rows - 8 ? rows - 8 : rw1); rw1 += 8;
        int rlo = 4 * rq - 4; rlo = rlo < 0 ? 0 : (rlo > rows - 8 ? rows - 8 : rlo);
        int rhi = 4 * rq - 1; rhi = rhi < 0 ? 0 : (rhi > rows - 8 ? rows - 8 : rhi); rhi += 8;
        const int NTu = rhi - rlo;
        const bf16* kg = proj + (size_t)row0 * DIN + C_NK + h * 64;
        const bf16* vg = proj + (size_t)row0 * DIN + C_NV + h * 64;
        NA_STAGE(0, rlo); NA_STAGE(1, rlo + 1); NA_STAGE(2, rlo + 2);
        bf16x8 qf[4];
        { const bf16* qp = proj + (size_t)(row0 + r * 64 + 16 * blk + (lane_u & 15)) * DIN + C_NQ + h * 64 + (lane_u >> 5) * 8;
#pragma unroll
          for (int ds = 0; ds < 4; ++ds) { float f[8]; unpack8(*(const v4u*)(qp + ds * 16), f);
              v4u w; w.x = cvtpk(f[0] * qsc, f[1] * qsc); w.y = cvtpk(f[2] * qsc, f[3] * qsc); w.z = cvtpk(f[4] * qsc, f[5] * qsc); w.w = cvtpk(f[6] * qsc, f[7] * qsc);
              qf[ds] = __builtin_bit_cast(bf16x8, w); } }
        { const int tix = wave * 64 + lane_u;
          if (tix < 15 * 31) { const int dr = tix / 31, dc = tix % 31; *(LAS float*)(L + NA_TBL + (dr * NA_TROW + 64 + dc) * 4) = rpb[h * 15 * 31 + tix] * LOG2E; }
          for (int p = tix; p < 15 * NA_TROW; p += NTHREADS) { const int dc = p % NA_TROW - 64; if (!((unsigned)dc < 31u)) *(LAS float*)(L + NA_TBL + p * 4) = 0.f; } }
        const unsigned tra_lo = (unsigned)(uintptr_t)L + trlo, tra_hi = (unsigned)(uintptr_t)L + trhi;
        f32x16 O[2];
#pragma unroll
        for (int db = 0; db < 2; ++db)
#pragma unroll
            for (int rr = 0; rr < 16; ++rr) O[db][rr] = 0.f;
        float m = 0.f, l = 0.f;
        float madd[16];
        { int vb = vbase; asm volatile("" : "+v"(vb));
#pragma unroll
          for (int rr = 0; rr < 16; ++rr) madd[rr] = ((unsigned)(vb + (rr & 3) + 8 * (rr >> 2)) < 16u) ? 0.f : -3e30f; }
#pragma unroll 1
        for (int t4 = 0; t4 < NTu; t4 += RT_NBUF) {
#pragma unroll
          for (int tb_ = 0; tb_ < RT_NBUF; ++tb_) {
            const int t = t4 + tb_;
            if (t < NTu) {
            const int kr = rlo + t;
            const LAS unsigned char* B = L + tb_ * RT_BUF;
            if (t + 2 < NTu) asm volatile("s_waitcnt vmcnt(4)" ::: "memory"); else if (t + 1 < NTu) asm volatile("s_waitcnt vmcnt(2)" ::: "memory"); else asm volatile("s_waitcnt vmcnt(0)" ::: "memory");
            __builtin_amdgcn_s_barrier(); asm volatile("" ::: "memory");
            if (t + 3 < NTu) NA_STAGE((tb_ + 3) & 3, kr + 3);
            if (kr >= rw0 && kr < rw1) {
                bf16x8 kf[4];
#pragma unroll
                for (int ds = 0; ds < 4; ++ds) kf[ds] = *(const LAS bf16x8*)(B + (kaddr0 ^ (unsigned)(ds << 5)));
                s16x4 vl[2][2], vh[2][2];
#pragma unroll
                for (int db = 0; db < 2; ++db)
#pragma unroll
                    for (int ks = 0; ks < 2; ++ks) { TR_READ(vl[db][ks], tra_lo, tb_ * RT_BUF + 2048 * ks + 512 * db); TR_READ(vh[db][ks], tra_hi, tb_ * RT_BUF + 2048 * ks + 512 * db); }
                int drl = kr - r + 7; const float rm = ((unsigned)(kr - rs) < 8u ? 0.f : -3e30f) - m;
                drl = drl < 0 ? 0 : (drl > 14 ? 14 : drl);
                const unsigned trow = tbase + (unsigned)(drl * NA_TROW * 4);
                f32x16 a0;
#pragma unroll
                for (int rr = 0; rr < 16; ++rr) { const int ko = (rr & 3) + 8 * (rr >> 2); a0[rr] = (*(const LAS float*)(L + trow + ko * 4) + madd[rr]) + rm; }
                __builtin_amdgcn_sched_barrier(0); LGKM_WAIT(0); __builtin_amdgcn_sched_barrier(0);
#pragma unroll
                for (int ds = 0; ds < 4; ++ds) a0 = __builtin_amdgcn_mfma_f32_32x32x16_bf16(kf[ds], qf[ds], a0, 0, 0, 0);
                float ls = 0.f;
#pragma unroll
                for (int rr = 0; rr < 16; ++rr) { const float p0 = __builtin_amdgcn_exp2f(a0[rr]); ls += p0; a0[rr] = p0; }
                if (__builtin_expect(__any(ls > 65536.f), 0)) {
                    const int e_ = __builtin_amdgcn_frexp_expf(ls) - 1; const float dl = half_max((float)(e_ > 0 ? e_ : 0)), alpha = __builtin_amdgcn_exp2f(-dl);
                    m += dl; l *= alpha; ls *= alpha;
#pragma unroll
                    for (int rr = 0; rr < 16; ++rr) a0[rr] *= alpha;
#pragma unroll
                    for (int db = 0; db < 2; ++db)
#pragma unroll
                        for (int rr = 0; rr < 16; ++rr) O[db][rr] *= alpha; }
                l += ls;
                bf16x8 pf[2];
#pragma unroll
                for (int sI = 0; sI < 2; ++sI) { v4u w; w.x = cvtpk(a0[8 * sI], a0[8 * sI + 1]); w.y = cvtpk(a0[8 * sI + 2], a0[8 * sI + 3]); w.z = cvtpk(a0[8 * sI + 4], a0[8 * sI + 5]); w.w = cvtpk(a0[8 * sI + 6], a0[8 * sI + 7]);
                    pf[sI] = __builtin_bit_cast(bf16x8, w); }
#pragma unroll
                for (int ks = 0; ks < 2; ++ks)
#pragma unroll
                    for (int db = 0; db < 2; ++db) O[db] = __builtin_amdgcn_mfma_f32_32x32x16_bf16(VFRAG(vl[db][ks], vh[db][ks]), pf[ks], O[db], 0, 0, 0);
            }
            asm volatile("s_waitcnt lgkmcnt(0)" ::: "memory");
            }
          }
        }
        const float inv = 1.f / half_sum(l);
        const int hh_u = lane_u >> 5;
        bf16* op = mix + (size_t)(row0 + r * 64 + 16 * blk + (lane_u & 15)) * DM + MIX_NA + h * 64;
#pragma unroll
        for (int db = 0; db < 2; ++db)
#pragma unroll
            for (int rp = 0; rp < 2; ++rp)
                store_pair16(op + 32 * db + 16 * rp, hh_u, cvtpk(O[db][8 * rp] * inv, O[db][8 * rp + 1] * inv), cvtpk(O[db][8 * rp + 2] * inv, O[db][8 * rp + 3] * inv),
                                                            cvtpk(O[db][8 * rp + 4] * inv, O[db][8 * rp + 5] * inv), cvtpk(O[db][8 * rp + 6] * inv, O[db][8 * rp + 7] * inv));
    }
#undef NA_STAGE
}

struct Args { const float* in[20]; float* out; unsigned char* ws; };
__global__ void __launch_bounds__(NTHREADS, 2) fwd_kernel(Args args) {
    extern __shared__ __attribute__((aligned(16))) unsigned char lds[];
    Frame F;
    F.lds = (LAS unsigned char*)lds;
    F.tid = threadIdx.x; F.lane = F.tid & 63; F.wave = __builtin_amdgcn_readfirstlane(F.tid >> 6);
    F.G = gridDim.x; F.bx = blockIdx.x;
    unsigned char* ws = args.ws;
    for (int u = F.tid; u < (LDS_BYTES - LDSCTL_OFF) / 4; u += NTHREADS) ((LAS unsigned*)(F.lds + LDSCTL_OFF))[u] = 0u;
    __syncthreads();
    XcdBarrier bar = xcd_barrier_post((unsigned*)(ws + WS_CTL) + CW_BAR, (volatile LAS unsigned*)(F.lds + MISC_OFF) + 8, F.wave);
#define GRID_BAR() xcd_barrier(bar)
    const bool chunked = (gridDim.x & 7u) == 0u && gridDim.x >= 16u;
    if (chunked) (void)xcd_barrier_post((unsigned*)(ws + WS_HBAR) + (blockIdx.x & 7u) * 4096u, (volatile LAS unsigned*)(F.lds + MISC_OFF) + 12, F.wave, gridDim.x >> 3);
#define CHUNK_BAR() do { if ((Gv & 7) == 0 && Gv >= 16) { XcdBarrier hb_; hb_.bar = (unsigned*)(ws + WS_HBAR) + ((unsigned)bx & 7u) * 4096u; hb_.x = xb_xcc_id(); hb_.st = (volatile LAS unsigned*)(F.lds + MISC_OFF) + 12; \
        hb_.wave = F.wave; hb_.np = (unsigned)Gv >> 3; xcd_barrier(hb_); } else GRID_BAR(); } while (0)

    unsigned char* ob = (unsigned char*)args.out;
    bf16* W_in = (bf16*)(ws + WS_WIN); bf16* W_out = (bf16*)(ob + OUT_WOUT); bf16* W_up = (bf16*)(ws + WS_WUP); bf16* W_dn = (bf16*)(ob + OUT_WDN);
    bf16* XB = (bf16*)(ws + WS_H); bf16* MIXb = (bf16*)(ob + OUT_MIX); bf16* PROJ = (bf16*)(ws + WS_PROJ); bf16* ACT = (bf16*)(ws + WS_PROJ);
    float* EPb = (float*)(ws + WS_ACT); float* EAb = EPb + (size_t)(MT / 256) * 2 * DFF; float* EGb = EAb + (size_t)(MT / 256) * 2 * DFF;
    ssq_t* SS = (ssq_t*)(ws + WS_SS);

    transpose_matrix<false>(F, args.in[3], DM, DIN, W_in, args.in[2]);
    convert_rows(F, args.in[0], XB, SS, MG);
    convert_rows(F, args.in[1], XB + (size_t)MG * DM, SS + MG, MG);
    GRID_BAR();

    for (int l = 0; l < DEPTH; ++l) {
        int bx = (int)blockIdx.x, Gv = (int)gridDim.x; asm volatile("" : "+s"(bx), "+s"(Gv)); F.G = Gv; F.bx = bx;
        { pg8::Gemm gm{XB, W_in + (size_t)l * DIN * DM, MT, DIN, DM}; pg8::StaticOrder SO; SO.init(MT, DIN, F.G, bx);
          EpiBf16Scale E{PROJ, DIN, SS + (size_t)(2 * l) * MT};
          pg8::gemm_phase<EpiBf16Scale, pg8::StaticOrder, true, true>(F.lds + RING_OFF, gm, SO, E, F.wave); }
        GRID_BAR();
        {
            float li_v = 0.8f - 0.6f * expf(-0.3f * (float)l); asm volatile("" : "+v"(li_v));
            unsigned li_u = __builtin_amdgcn_readfirstlane(__float_as_uint(li_v)); asm volatile("" : "+s"(li_u));
            const float lam_init = __uint_as_float(li_u);
            const float d1 = wave_sum(args.in[8][l * 64 + F.lane] * args.in[9][l * 64 + F.lane]);
            const float d2 = wave_sum(args.in[10][l * 64 + F.lane] * args.in[11][l * 64 + F.lane]);
            const float lam = __uint_as_float(__builtin_amdgcn_readfirstlane(__float_as_uint(expf(d1) - expf(d2) + lam_init)));
            unsigned* qc = (unsigned*)(ws + WS_CTL) + CW_QUEUE + l * 6 * 64;
            const bf16* P1 = PROJ + (size_t)MG * DIN; bf16* M1 = MIXb + (size_t)MG * DM;
            if (l == 0) { const int nbg = Gv < NBG ? Gv : NBG;
              if (bx < nbg) { F.G = nbg;
                for (int l2 = 0; l2 < DEPTH; ++l2) {
                    if (l2 > 0) transpose_matrix<false>(F, args.in[3] + (size_t)l2 * DM * DIN, DM, DIN, W_in + (size_t)l2 * DIN * DM, args.in[2] + l2 * DM);
                    transpose_matrix<false>(F, args.in[13] + (size_t)l2 * DM * DM, DM, DM, W_out + (size_t)l2 * DM * DM, nullptr);
                    transpose_matrix<true>(F, args.in[15] + (size_t)l2 * DM * DUP, DM, DUP, W_up + (size_t)l2 * DUP * DM, args.in[14] + l2 * DM);
                    transpose_matrix<false>(F, args.in[18] + (size_t)l2 * DFF * DM, DFF, DM, W_dn + (size_t)l2 * DM * DFF, nullptr); }
                F.G = Gv; asm volatile("s_waitcnt vmcnt(0) lgkmcnt(0)" ::: "memory"); __syncthreads(); } }
            if (F.wave >= 4) __builtin_amdgcn_s_setprio(1);
            diff_mfma(F, P1, M1, args.in[12] + l * 768, lam, lam_init, 4096, 4, qc);
            diff_mfma(F, PROJ, MIXb, args.in[12] + l * 768, lam, lam_init, 2048, 8, qc + 64);
            ret_mfma(F, P1, M1, args.in[4] + l * 8, args.in[5] + l * 8, args.in[6] + l * 512, 4096, 4, qc + 128);
            ret_mfma(F, PROJ, MIXb, args.in[4] + l * 8, args.in[5] + l * 8, args.in[6] + l * 512, 2048, 8, qc + 192);
            na_mfma(F, P1, M1, args.in[7] + l * NA_H * 15 * 31, 4096, 4, qc + 256);
            na_mfma(F, PROJ, MIXb, args.in[7] + l * NA_H * 15 * 31, 2048, 8, qc + 320);
            __builtin_amdgcn_s_setprio(0);
        }
        GRID_BAR();
        { pg8::Gemm gm{MIXb, W_out + (size_t)l * DM * DM, MT, DM, DM}; pg8::StaticOrder SO; SO.init(MT, DM, F.G, bx);
          EpiResNorm E{XB, XB, SS + (size_t)(2 * l + 1) * MT, DM};
          pg8::gemm_phase<EpiResNorm, pg8::StaticOrder, true, true>(F.lds + RING_OFF, gm, SO, E, F.wave); }
        CHUNK_BAR();
        { pg8::Gemm gm{XB, W_up + (size_t)l * DUP * DM, MT, DUP, DM}; pg8::StaticOrder SO; SO.init(MT, DUP, F.G, bx);
          EpiUpConv E{ACT, SS + (size_t)(2 * l + 1) * MT, args.in[16] + (size_t)l * 3 * DFF, args.in[17] + (size_t)l * DFF, EPb, EAb, EGb, F.lds + RING_OFF};
          pg8::gemm_phase<EpiUpConv, pg8::StaticOrder, true, true>(F.lds + RING_OFF, gm, SO, E, F.wave); }
        CHUNK_BAR();
        { pg8::Gemm gm{ACT, W_dn + (size_t)l * DM * DFF, MT, DM, DFF}; pg8::StaticOrder SO; SO.init(MT, DM, F.G, bx);
          { frame_refresh(F); pg8::Unit uu; int lastpm = -1;
            for (int ui = 0; SO.next(ui, uu); ++ui) if (uu.pm != lastpm) { ffn_edge_fixup_panel(F, ACT, EPb, EAb, EGb, args.in[16] + (size_t)l * 3 * DFF, uu.pm < MG / 256 ? 2048 : 4096, uu.pm); lastpm = uu.pm; }
            asm volatile("s_waitcnt vmcnt(0)" ::: "memory"); __syncthreads(); }
          EpiResNorm E{XB, XB, SS + (size_t)(2 * l + 2) * MT, DM};
          pg8::gemm_phase<EpiResNorm, pg8::StaticOrder, true, true>(F.lds + RING_OFF, gm, SO, E, F.wave); }
        GRID_BAR();
    }
    final_norm_rows(F, XB, SS + (size_t)4 * MT, args.in[19], args.out, MT);
}

extern "C" void kernel_launch(void* const* d_in, const int* in_sizes, int n_in, void* d_out, int out_size, void* d_ws, size_t ws_size, hipStream_t stream) {
    static int grid = 0;
    if (grid == 0) {
        if (n_in != 20 || out_size != 2 * MG * DM || ws_size < WS_END) { fprintf(stderr, "kernel_launch: unexpected shapes / workspace (n_in %d out %d ws %zu); nothing launched\n", n_in, out_size, ws_size); grid = -1; return; }
        int dev = 0, cus = 0, per_cu = 0;
        if (hipGetDevice(&dev) != hipSuccess || hipDeviceGetAttribute(&cus, hipDeviceAttributeMultiprocessorCount, dev) != hipSuccess) { grid = -1; return; }
        if (hipFuncSetAttribute((const void*)fwd_kernel, hipFuncAttributeMaxDynamicSharedMemorySize, LDS_BYTES) != hipSuccess) { fprintf(stderr, "kernel_launch: hipFuncSetAttribute failed\n"); grid = -1; return; }
        if (hipOccupancyMaxActiveBlocksPerMultiprocessor(&per_cu, (const void*)fwd_kernel, NTHREADS, LDS_BYTES) != hipSuccess || per_cu < 1) { fprintf(stderr, "kernel_launch: occupancy query reports %d\n", per_cu); }
        (void)hipGetLastError();
        grid = cus;
    }
    if (grid < 0) return;
    if (hipMemsetAsync((char*)d_ws + WS_CTL, 0, CTL_ZERO_BYTES, stream) != hipSuccess) return;
    Args a{};
    for (int i = 0; i < 20; ++i) a.in[i] = (const float*)d_in[i];
    a.out = (float*)d_out; a.ws = (unsigned char*)d_ws;
    hipLaunchKernelGGL(fwd_kernel, dim3(grid), dim3(NTHREADS), LDS_BYTES, stream, a);
}
```

```cpp
#include <hip/hip_runtime.h>
#include <cstdio>
#include <cstdint>

__device__ __forceinline__ int lane_id_now() { int ln; asm volatile("v_mbcnt_lo_u32_b32 %0, -1, 0\n\tv_mbcnt_hi_u32_b32 %0, -1, %0" : "=v"(ln)); return ln; }
namespace pg8 {
#define PG8_LAS __attribute__((address_space(3)))
typedef unsigned short bf16_t;
typedef short bf16x8 __attribute__((ext_vector_type(8)));
typedef float f32x4 __attribute__((ext_vector_type(4)));
typedef unsigned u32x4 __attribute__((ext_vector_type(4)));
constexpr int BM = 256, BK = 64, HALF = 128, HTB = HALF * BK * 2  , STAGE_BYTES = 8 * HTB, NXCD = 8, WGM = 8;

__host__ __device__ __forceinline__ int lds_byte(int r, int c) { const int st = (r >> 4) * 2 + (c >> 5), rr = r & 15, cc = c & 31, ob = rr * 64 + cc * 2; return st * 1024 + (ob ^ (((ob >> 9) & 1) << 5)); }
__host__ __device__ __forceinline__ void stage_rc(int b, int& R, int& C) { const int st = b / 1024, sb = b % 1024, swz = sb ^ (((sb >> 9) & 1) << 5); R = (st >> 1) * 16 + swz / 64; C = (st & 1) * 32 + (swz % 64) / 2; }
__host__ __device__ __forceinline__ int perm32(int rho) { const int n = rho >> 4, i = rho & 15; return 8 * (i >> 2) + 4 * n + (i & 3); }

struct Unit { int pm, pn; };
struct Gemm { const bf16_t* A; const bf16_t* Bt; int M, N, K; };

struct StaticOrder {
    int nM, nN, nwg, G, c;
    __host__ __device__ void init(int M, int N, int G_, int c_) { nM = M / BM; nN = N / BM; nwg = nM * nN; G = G_; c = c_; }
    __host__ __device__ bool next(int i, Unit& u) const {
        const long L = (long)i * G + c; if (L >= nwg) return false;
        int wgid = (int)L; { const int q = nwg / NXCD, r = nwg % NXCD, xcd = wgid % NXCD, off = wgid / NXCD; wgid = (xcd < r ? xcd * (q + 1) : r * (q + 1) + (xcd - r) * q) + off; }
        const int nig = WGM * nN, gid = wgid / nig, fm = gid * WGM, gsz = (nM - fm) < WGM ? (nM - fm) : WGM;
        u.pm = fm + ((wgid % nig) % gsz); u.pn = (wgid % nig) / gsz; return true;
    }
    __device__ __forceinline__ void a_ready(const Unit&) const {}
    __device__ __forceinline__ void done(const Unit&) const {}
};

__device__ __forceinline__ unsigned cvt_pk_bf16(float lo, float hi) { unsigned r; asm volatile("v_cvt_pk_bf16_f32 %0, %1, %2" : "=v"(r) : "v"(lo), "v"(hi)); return r; }

template <class Epi, class Sched, bool ALIGN_EPI = false, bool SP2 = false>
__device__ __forceinline__ void gemm_phase(PG8_LAS unsigned char* lds, const Gemm g, const Sched& S, const Epi& E, int wave_id) {
    int tid_ = wave_id * 64 + lane_id_now();
    const int tid = tid_, wid = __builtin_amdgcn_readfirstlane(tid >> 6), lane = tid & 63, wr = wid >> 2, wc = wid & 3, fr = lane & 15, fq = lane >> 4;
    const int K = g.K, nt = K / BK;
    unsigned voffA[2], voffB[2];
#pragma unroll
    for (int i = 0; i < 2; ++i) { int R, C; stage_rc(tid * 16 + i * 8192, R, C); const int Rb = Epi::PERM ? ((R & ~31) + perm32(R & 31)) : R;
        voffA[i] = (unsigned)(R * K + C) * 2u; voffB[i] = (unsigned)(Rb * K + C) * 2u; }
    const size_t kstep = (size_t)(BK * 2);
    const size_t hstep = (size_t)HALF * K * 2;
    const size_t tstep = 2 * hstep;
    const unsigned ldsw = (unsigned)wid * 1024u;
    const int aoff = lds_byte(wr * 64 + fr, fq * 8), boff = lds_byte(wc * 32 + fr, fq * 8);
#define PG8_SA(b, h) (((b) * 2 + (h)) * HTB)
#define PG8_SB(b, h) ((4 + (b) * 2 + (h)) * HTB)
#define PG8_STAGE(bufoff, gbase, voff) do { _Pragma("unroll") for (int _i = 0; _i < 2; ++_i) \
        __builtin_amdgcn_global_load_lds((const unsigned*)((const char*)(gbase) + (voff)[_i]), (PG8_LAS unsigned*)(lds + (bufoff) + ldsw + _i * 8192), 16, 0, 0); } while (0)
#define PG8_LDA(dst, b, h) do { _Pragma("unroll") for (int m = 0; m < 4; ++m) _Pragma("unroll") for (int k = 0; k < 2; ++k) dst[m][k] = *(const PG8_LAS bf16x8*)(lds + PG8_SA(b, h) + aoff + m * 2048 + k * 1024); } while (0)
#define PG8_LDB(dst, b, h) do { _Pragma("unroll") for (int n = 0; n < 2; ++n) _Pragma("unroll") for (int k = 0; k < 2; ++k) dst[n][k] = *(const PG8_LAS bf16x8*)(lds + PG8_SB(b, h) + boff + n * 2048 + k * 1024); } while (0)
#define PG8_MMA(ai, bj, At, Bt) do { __builtin_amdgcn_s_setprio(1); _Pragma("unroll") for (int m = 0; m < 4; ++m) _Pragma("unroll") for (int n = 0; n < 2; ++n) _Pragma("unroll") for (int k = 0; k < 2; ++k) \
        acc[ai][bj][m][n] = __builtin_amdgcn_mfma_f32_16x16x32_bf16(Bt[n][k], At[m][k], acc[ai][bj][m][n], 0, 0, 0); __builtin_amdgcn_s_setprio(0); } while (0)
#define PG8_WAIT_V(n) asm volatile("s_waitcnt vmcnt(" #n ")" ::: "memory")
#define PG8_WAIT_L(n) asm volatile("s_waitcnt lgkmcnt(" #n ")" ::: "memory")
#define PG8_BAR __builtin_amdgcn_s_barrier()
#define PG8_SCHED __builtin_amdgcn_sched_barrier(0)
    Unit cur, nxt; int ui = 0;
    if (!S.next(0, cur)) return;
    f32x4 acc[2][2][4][2];
#pragma unroll
    for (int a = 0; a < 2; ++a)
#pragma unroll
        for (int b = 0; b < 2; ++b)
#pragma unroll
            for (int m = 0; m < 4; ++m)
#pragma unroll
                for (int n = 0; n < 2; ++n) acc[a][b][m][n] = (f32x4){0.f, 0.f, 0.f, 0.f};
    bf16x8 At[4][2], B0[2][2], B1[2][2];
    const char* cA = (const char*)g.A + (size_t)cur.pm * tstep; const char* cB = (const char*)g.Bt + (size_t)cur.pn * tstep;
    S.a_ready(cur);
    if constexpr (SP2) {
        PG8_STAGE(PG8_SB(0, 0), cB, voffB); PG8_STAGE(PG8_SB(0, 1), cB + hstep, voffB); PG8_STAGE(PG8_SA(0, 0), cA, voffA); PG8_STAGE(PG8_SA(0, 1), cA + hstep, voffA);
        if (wr == 1) PG8_BAR;
        PG8_WAIT_V(2); PG8_BAR;
        PG8_STAGE(PG8_SB(1, 0), cB + kstep, voffB); PG8_STAGE(PG8_SA(1, 0), cA + kstep, voffA); PG8_STAGE(PG8_SB(1, 1), cB + hstep + kstep, voffB);
        PG8_WAIT_V(6); PG8_BAR;
    } else {
        PG8_STAGE(PG8_SB(0, 0), cB, voffB); PG8_STAGE(PG8_SA(0, 0), cA, voffA); PG8_STAGE(PG8_SB(0, 1), cB + hstep, voffB); PG8_STAGE(PG8_SA(0, 1), cA + hstep, voffA);
        if (wr == 1) PG8_BAR;
        PG8_WAIT_V(4); PG8_BAR;
        PG8_STAGE(PG8_SB(1, 0), cB + kstep, voffB); PG8_STAGE(PG8_SA(1, 0), cA + kstep, voffA); PG8_STAGE(PG8_SB(1, 1), cB + hstep + kstep, voffB);
        PG8_WAIT_V(6); PG8_BAR;
    }
    for (;;) {
        const bool has_next = S.next(ui + 1, nxt);
        const char* nA = has_next ? (const char*)g.A + (size_t)nxt.pm * tstep : cA; const char* nB = has_next ? (const char*)g.Bt + (size_t)nxt.pn * tstep : cB;
        for (int t = 0; t < nt; t += 2) {
            const bool last = (t == nt - 2);
            const char* a1 = cA + (size_t)(t + 1) * kstep;
            const char* a2 = last ? nA : cA + (size_t)(t + 2) * kstep; const char* b2 = last ? nB : cB + (size_t)(t + 2) * kstep;
            const char* a3 = a2 + kstep; const char* b3 = b2 + kstep;
            if (last && has_next) S.a_ready(nxt);
            if constexpr (SP2) {
            PG8_LDB(B0, 0, 0); PG8_LDB(B1, 0, 1); PG8_SCHED; PG8_LDA(At, 0, 0); PG8_STAGE(PG8_SA(1, 1), a1 + hstep, voffA);
            PG8_WAIT_V(8); PG8_WAIT_L(0); PG8_BAR; PG8_MMA(0, 0, At, B0); PG8_MMA(0, 1, At, B1); PG8_BAR; PG8_SCHED;
            PG8_LDA(At, 0, 1); PG8_STAGE(PG8_SB(0, 0), b2, voffB); PG8_STAGE(PG8_SB(0, 1), b2 + hstep, voffB); PG8_STAGE(PG8_SA(0, 0), a2, voffA);
            PG8_WAIT_V(8); PG8_WAIT_L(0); PG8_BAR; PG8_MMA(1, 0, At, B0); PG8_MMA(1, 1, At, B1); PG8_BAR; PG8_SCHED;
            PG8_LDB(B0, 1, 0); PG8_LDB(B1, 1, 1); PG8_SCHED; PG8_LDA(At, 1, 0); PG8_STAGE(PG8_SA(0, 1), a2 + hstep, voffA);
            PG8_WAIT_V(8); PG8_WAIT_L(0); PG8_BAR; PG8_MMA(0, 0, At, B0); PG8_MMA(0, 1, At, B1); PG8_BAR; PG8_SCHED;
            PG8_LDA(At, 1, 1); PG8_STAGE(PG8_SB(1, 0), b3, voffB); PG8_STAGE(PG8_SB(1, 1), b3 + hstep, voffB); PG8_STAGE(PG8_SA(1, 0), a3, voffA);
            PG8_WAIT_V(8); PG8_WAIT_L(0); PG8_BAR; PG8_MMA(1, 0, At, B0); PG8_MMA(1, 1, At, B1); PG8_BAR; PG8_SCHED;
            } else {
            PG8_LDB(B0, 0, 0); PG8_SCHED; PG8_LDA(At, 0, 0); PG8_STAGE(PG8_SA(1, 1), a1 + hstep, voffA);
            PG8_WAIT_L(8); PG8_BAR; PG8_WAIT_L(0); PG8_MMA(0, 0, At, B0); PG8_BAR; PG8_SCHED;
            PG8_LDB(B1, 0, 1); PG8_STAGE(PG8_SB(0, 0), b2, voffB);
            PG8_BAR; PG8_WAIT_L(0); PG8_MMA(0, 1, At, B1); PG8_BAR;
            PG8_LDA(At, 0, 1); PG8_STAGE(PG8_SA(0, 0), a2, voffA);
            PG8_BAR; PG8_WAIT_L(0); PG8_MMA(1, 0, At, B0); PG8_BAR; PG8_SCHED;
            PG8_STAGE(PG8_SB(0, 1), b2 + hstep, voffB);
            PG8_WAIT_V(6); PG8_BAR; PG8_MMA(1, 1, At, B1); PG8_BAR;
            PG8_LDB(B0, 1, 0); PG8_SCHED; PG8_LDA(At, 1, 0); PG8_STAGE(PG8_SA(0, 1), a2 + hstep, voffA);
            PG8_WAIT_L(8); PG8_BAR; PG8_WAIT_L(0); PG8_MMA(0, 0, At, B0); PG8_BAR; PG8_SCHED;
            PG8_LDB(B1, 1, 1); PG8_STAGE(PG8_SB(1, 0), b3, voffB);
            PG8_BAR; PG8_WAIT_L(0); PG8_MMA(0, 1, At, B1); PG8_BAR;
            PG8_LDA(At, 1, 1); PG8_STAGE(PG8_SA(1, 0), a3, voffA);
            PG8_BAR; PG8_WAIT_L(0); PG8_MMA(1, 0, At, B0); PG8_BAR; PG8_SCHED;
            PG8_STAGE(PG8_SB(1, 1), b3 + hstep, voffB);
            PG8_WAIT_V(6); PG8_BAR; PG8_MMA(1, 1, At, B1); PG8_BAR;
            }
        }
        if constexpr (ALIGN_EPI) { if (wr == 0) PG8_BAR; }
        if constexpr (!Epi::AFTER_DRAIN) { E(acc, cur, wr, wc, fr, fq); S.done(cur); }
        if (!has_next) break;
#pragma unroll
        for (int a = 0; a < 2; ++a)
#pragma unroll
            for (int b = 0; b < 2; ++b)
#pragma unroll
                for (int m = 0; m < 4; ++m)
#pragma unroll
                    for (int n = 0; n < 2; ++n) acc[a][b][m][n] = (f32x4){0.f, 0.f, 0.f, 0.f};
        cur = nxt; cA = nA; cB = nB; ++ui;
        if constexpr (ALIGN_EPI) { if (wr == 1) PG8_BAR; }
    }
    PG8_WAIT_V(0);
    if constexpr (!ALIGN_EPI) { if (wr == 0) PG8_BAR; }
    PG8_BAR;
#undef PG8_SA
#undef PG8_SB
#undef PG8_STAGE
#undef PG8_LDA
#undef PG8_LDB
#undef PG8_MMA
#undef PG8_WAIT_V
#undef PG8_WAIT_L
#undef PG8_BAR
#undef PG8_SCHED
}
}

constexpr int NWAVES = 8, NTHREADS = NWAVES * 64;
constexpr int DM = 2048, DIN = 6656, DFF = 5632, DUP = 2 * DFF, DEPTH = 2;
constexpr int MG = 16384;
constexpr int RET_H = 8, NA_H = 12, DIFF_H = 6;
constexpr int C_RQ = 0, C_RK = 512, C_RV = 1024, C_RG = 1536, C_NQ = 2048, C_NK = 2816, C_NV = 3584, C_DQ = 4352, C_DK = 5120, C_DV = 5888;
constexpr int MIX_RET = 0, MIX_NA = 512, MIX_DIFF = 1280;
constexpr float NORM_EPS = 1e-6f;
constexpr float LOG2E = 1.4426950408889634f;

constexpr size_t MiB = 1u << 20;
constexpr size_t WS_CTL = 0, CTL_ZERO_BYTES = 2 * MiB;
constexpr int MT = 2 * MG;
constexpr size_t WS_WIN = 2 * MiB;
constexpr size_t WS_WUP = 54 * MiB;
constexpr size_t WS_H = 142 * MiB;
constexpr size_t WS_PROJ = 270 * MiB;
constexpr size_t WS_ACT = 686 * MiB;
constexpr size_t WS_END = 703 * MiB;
constexpr size_t OUT_MIX = 0;
constexpr size_t OUT_WOUT = 128 * MiB;
constexpr size_t OUT_WDN = 144 * MiB;
static_assert(OUT_WDN + 44 * MiB <= (size_t)MT * DM * 4 && WS_ACT + (size_t)3 * (MT / 256) * 2 * DFF * 4 <= WS_END && WS_PROJ + (size_t)MT * DIN * 2 <= WS_ACT, "workspace map");
constexpr int NBG = 64;
constexpr int CW_BAR = 4096;
constexpr int CW_QUEUE = 8192;
constexpr size_t WS_HBAR = 3 * MiB / 2;
constexpr size_t WS_SS = 65536;
static_assert(WS_SS + (size_t)2 * 5 * MG * 8 <= CTL_ZERO_BYTES && CTL_ZERO_BYTES <= WS_WIN && (CW_BAR + 3456) <= CW_QUEUE && (CW_QUEUE + 12 * 64) * 4 <= (int)WS_SS, "CTL map");

constexpr int RING_OFF = 0, RING_BYTES = 143360;
constexpr int LDSCTL_OFF = RING_BYTES, MISC_OFF = LDSCTL_OFF + 320;
constexpr int LDS_BYTES = 147456;

#define GAS __attribute__((address_space(1)))
#define LAS __attribute__((address_space(3)))
typedef unsigned short bf16;
typedef unsigned v4u __attribute__((ext_vector_type(4)));
typedef float f32x4 __attribute__((ext_vector_type(4)));
typedef GAS unsigned gu32;
#define RLX_AGENT __ATOMIC_RELAXED, __HIP_MEMORY_SCOPE_AGENT
#define LDS_WAIT() asm volatile("s_waitcnt lgkmcnt(0)" ::: "memory")
__device__ __forceinline__ unsigned f2bf(float f) { unsigned u = __builtin_bit_cast(unsigned, f); return (u + 0x7fffu + ((u >> 16) & 1u)) >> 16; }
__device__ __forceinline__ unsigned pk2(float lo, float hi) { return f2bf(lo) | (f2bf(hi) << 16); }
__device__ __forceinline__ float bflo(unsigned u) { return __uint_as_float(u << 16); }
__device__ __forceinline__ float bfhi(unsigned u) { return __uint_as_float(u & 0xffff0000u); }
__device__ __forceinline__ void unpack8(const v4u v, float* f) { f[0] = bflo(v.x); f[1] = bfhi(v.x); f[2] = bflo(v.y); f[3] = bfhi(v.y); f[4] = bflo(v.z); f[5] = bfhi(v.z); f[6] = bflo(v.w); f[7] = bfhi(v.w); }

#define XB_TMO      128
#define XB_XCNT(j)  (256  + 64 * (j))
#define XB_XSUB(j)  (1280 + 64 * (j))
#define XB_XGEN(j)  (2304 + 64 * (j))
#define XB_TOP      3328
#define XB_TOPGEN   3392
#define XCD_BAR_WORDS 3456
#define XB_SPIN_CAP (1u << 22)

__device__ __forceinline__ unsigned xb_ld(unsigned* p)              { return __hip_atomic_load(p, __ATOMIC_RELAXED, __HIP_MEMORY_SCOPE_AGENT); }
__device__ __forceinline__ unsigned xb_add(unsigned* p, unsigned v) { return __hip_atomic_fetch_add(p, v, __ATOMIC_RELAXED, __HIP_MEMORY_SCOPE_AGENT); }
__device__ __forceinline__ unsigned xb_xcc_id() { return (unsigned)__builtin_amdgcn_s_getreg((3 << 11) | 20) & 0xFu; }
#define XB_SPIN(cond, bar) do { unsigned _sp = 0; while (cond) { __builtin_amdgcn_s_sleep(1); \
    if ((++_sp & 255u) == 0u) { if (xb_ld(&(bar)[XB_TMO])) break; if (_sp > XB_SPIN_CAP) { __hip_atomic_store(&(bar)[XB_TMO], 1u, __ATOMIC_RELAXED, __HIP_MEMORY_SCOPE_AGENT); break; } } } } while (0)

struct XcdBarrier { unsigned* bar; unsigned x; volatile LAS unsigned* st; int wave; unsigned np; };

__device__ __forceinline__ XcdBarrier xcd_barrier_post(unsigned* bar, volatile LAS unsigned* st, int wave, unsigned np = 0u) {
    XcdBarrier b; b.bar = bar; b.x = xb_xcc_id(); b.st = st; b.wave = wave; b.np = np;
    if (threadIdx.x == 0) (void)xb_add(&bar[XB_XCNT(b.x)], 1u);
    return b;
}
__device__ __forceinline__ void xcd_barrier_complete(unsigned* bar, unsigned x, unsigned& nloc, unsigned& nx, unsigned np) {
    asm volatile("" : "+s"(x));
    const unsigned G = np ? np : gridDim.x * gridDim.y * gridDim.z;
    unsigned sum, cnt, mine, sp = 0u;
    for (;;) {
        sum = 0u; cnt = 0u; mine = 0u;
#pragma unroll
        for (unsigned j = 0; j < 16; ++j) { const unsigned c = xb_ld(&bar[XB_XCNT(j)]); sum += c; cnt += (c > 0u) ? 1u : 0u; mine = (j == x) ? c : mine; }
        if (sum == G) break;
        __builtin_amdgcn_s_sleep(1);
        if ((++sp & 255u) == 0u) { if (xb_ld(&bar[XB_TMO])) break; if (sp > XB_SPIN_CAP) { __hip_atomic_store(&bar[XB_TMO], 1u, __ATOMIC_RELAXED, __HIP_MEMORY_SCOPE_AGENT); break; } }
    }
    nloc = mine > 0u ? mine : 1u; nx = cnt > 0u ? cnt : 1u;
}
__device__ __forceinline__ void xcd_barrier(const XcdBarrier& b) {
    asm volatile("s_waitcnt vmcnt(0)" ::: "memory");
    __syncthreads();
    if (b.wave == 0 && lane_id_now() == 0) {
        unsigned* bar = b.bar; asm volatile("" : "+s"(bar));
        __builtin_amdgcn_s_waitcnt(0);
        unsigned nloc = b.st[0], nx = b.st[1];
        if (nloc == 0u) { xcd_barrier_complete(bar, b.x, nloc, nx, b.np); b.st[0] = nloc; b.st[1] = nx; }
        const unsigned old = xb_add(&bar[XB_XSUB(b.x)], 1u);
        const unsigned gen = old / nloc;
        if (old + 1u == (gen + 1u) * nloc) {
            __builtin_amdgcn_fence(__ATOMIC_RELEASE, "agent");
            asm volatile("s_waitcnt vmcnt(0)" ::: "memory");
            const unsigned og = xb_add(&bar[XB_TOP], 1u);
            const unsigned tg = og / nx;
            if (og + 1u == (tg + 1u) * nx) xb_add(&bar[XB_TOPGEN], 1u);
            else XB_SPIN(xb_ld(&bar[XB_TOPGEN]) == tg, bar);
            __builtin_amdgcn_fence(__ATOMIC_ACQUIRE, "agent");
            xb_add(&bar[XB_XGEN(b.x)], 1u);
            asm volatile("s_waitcnt vmcnt(0)" ::: "memory");
        } else {
            XB_SPIN(xb_ld(&bar[XB_XGEN(b.x)]) == gen, bar);
            __builtin_amdgcn_fence(__ATOMIC_ACQUIRE, "agent");
            asm volatile("s_waitcnt vmcnt(0)" ::: "memory");
        }
    }
    __syncthreads();
}

struct Frame {
    LAS unsigned char* lds;
    int tid, lane, wave;
    int G, bx;
};
__device__ __forceinline__ void frame_refresh(Frame& F) { int ln = lane_id_now();
    F.lane = ln; F.tid = F.wave * 64 + ln; }
template <int O> __device__ __forceinline__ float swz_xor(float v) { return __int_as_float(__builtin_amdgcn_ds_swizzle(__float_as_int(v), (O << 10) | 0x1f)); }
__device__ __forceinline__ void mul_inplace(float& x, float a) { asm volatile("v_mul_f32 %0, %0, %1" : "+v"(x) : "v"(a)); }
__device__ __forceinline__ int q_next(unsigned* ctr, volatile LAS int* slot, int wave, int lane) {
    __syncthreads();
    if (wave == 0 && lane == 0) *slot = (int)__hip_atomic_fetch_add(ctr, 1u, __ATOMIC_RELAXED, __HIP_MEMORY_SCOPE_AGENT);
    __syncthreads();
    return *slot;
}
__device__ __forceinline__ void store_pair16(bf16* rowp_k, int hh, unsigned ax, unsigned ay, unsigned bx, unsigned by) {
    auto r0 = __builtin_amdgcn_permlane32_swap(ax, bx, false, false); auto r1 = __builtin_amdgcn_permlane32_swap(ay, by, false, false);
    v4u w; w.x = r0[0]; w.y = r1[0]; w.z = r0[1]; w.w = r1[1];
    *(v4u*)(rowp_k + 8 * hh) = w;
}
__device__ __forceinline__ float wave_sum(float v) {
    v += swz_xor<1>(v); v += swz_xor<2>(v); v += swz_xor<4>(v); v += swz_xor<8>(v); v += swz_xor<16>(v);
    auto rr = __builtin_amdgcn_permlane32_swap(__float_as_uint(v), __float_as_uint(v), false, false);
    return __uint_as_float(rr[0]) + __uint_as_float(rr[1]);
}

template <bool UPMAP> __device__ __forceinline__ void p0_transpose_item(const float* W, int K, int N, bf16* WT, const float* gain, LAS float* scr, int item, int lane) {
    const int nblk = N / 64, kb = item / nblk, nb = item % nblk, k0 = 64 * kb, n0 = 64 * nb;
    const int lr = lane >> 4, lc = (lane & 15) * 4;
    f32x4 v[16]; float gsc[16];
#pragma unroll
    for (int i = 0; i < 16; ++i) { const int kk = 4 * i + lr; gsc[i] = gain ? gain[k0 + kk] : 1.f; v[i] = *(const GAS f32x4*)(W + (size_t)(k0 + kk) * N + n0 + lc); }
#pragma unroll
    for (int i = 0; i < 16; ++i) { const int kk = 4 * i + lr; LAS float* d = scr + kk * 65 + lc; d[0] = v[i].x * gsc[i]; d[1] = v[i].y * gsc[i]; d[2] = v[i].z * gsc[i]; d[3] = v[i].w * gsc[i]; }
    LDS_WAIT(); asm volatile("" ::: "memory");
    const int c = lane & 7;
    int r0 = n0;
    if (UPMAP) { const int isg = n0 >= DFF ? 1 : 0, chn = n0 - isg * DFF; r0 = 256 * (chn / 128) + 128 * isg + (chn % 128); }
#pragma unroll
    for (int j = 0; j < 8; ++j) { const int n = (lane >> 3) + 8 * j; const LAS float* sp = scr + (8 * c) * 65 + n;
        v4u o; o.x = pk2(sp[0 * 65], sp[1 * 65]); o.y = pk2(sp[2 * 65], sp[3 * 65]); o.z = pk2(sp[4 * 65], sp[5 * 65]); o.w = pk2(sp[6 * 65], sp[7 * 65]);
        *(GAS v4u*)(WT + (size_t)(r0 + n) * K + k0 + 8 * c) = o; }
    LDS_WAIT(); asm volatile("" ::: "memory");
}
template <bool UPMAP> __device__ __forceinline__ void transpose_matrix(Frame& F, const float* W, int K, int N, bf16* WT, const float* gain, int bx0 = 0, int nb = 0) {
    LAS float* scr = (LAS float*)(F.lds + RING_OFF + F.wave * 16640);
    const int gw = (F.bx - bx0) * NWAVES + F.wave, NGW = (nb ? nb : F.G) * NWAVES;
    const int nitems = (K / 64) * (N / 64);
    for (int it = gw; it < nitems; it += NGW) p0_transpose_item<UPMAP>(W, K, N, WT, gain, scr, it, F.lane);
}

typedef unsigned long long ssq_t;
__device__ __forceinline__ ssq_t ss_pack(float v) { const float hi = floorf(v); return ((ssq_t)(unsigned)hi << 24) + (ssq_t)(unsigned)((v - hi) * 16777216.f); }
__device__ __forceinline__ float ss_unpack(ssq_t q) { return __builtin_fmaf((float)(unsigned)(q >> 32), 256.f, (float)(unsigned)(q & 0xffffffffull) * (1.f / 16777216.f)); }
__device__ __forceinline__ void convert_rows(Frame& F, const float* xin, bf16* xb, ssq_t* ss, int nrows) {
    frame_refresh(F);
    const int gw = F.bx * NWAVES + F.wave, NGW = F.G * NWAVES;
    for (int m = gw; m < nrows; m += NGW) {
        const GAS f32x4* xr = (const GAS f32x4*)(xin + (size_t)m * DM) + F.lane;
        f32x4 v[8]; float sq = 0.f;
#pragma unroll
        for (int j = 0; j < 8; ++j) { v[j] = xr[64 * j]; sq += (v[j].x * v[j].x + v[j].y * v[j].y) + (v[j].z * v[j].z + v[j].w * v[j].w); }
        sq = wave_sum(sq);
        GAS unsigned long long* o8 = (GAS unsigned long long*)(xb + (size_t)m * DM) + F.lane;
#pragma unroll
        for (int j = 0; j < 8; ++j) o8[64 * j] = (unsigned long long)pk2(v[j].x, v[j].y) | ((unsigned long long)pk2(v[j].z, v[j].w) << 32);
        if (F.lane == 0) ss[m] = ss_pack(sq);
    }
}
__device__ __forceinline__ void final_norm_rows(Frame& F, const bf16* xb, const ssq_t* ss, const float* w, float* out, int nrows, int bx0 = 0, int nb = 0) {
    frame_refresh(F);
    const int gw = (F.bx - bx0) * NWAVES + F.wave, NGW = (nb ? nb : F.G) * NWAVES;
    for (int m = gw; m < nrows; m += NGW) {
        const float rstd = 1.f / sqrtf(ss_unpack(ss[m]) * (1.f / DM) + NORM_EPS);
#pragma unroll
        for (int j = 0; j < 4; ++j) { const int c0 = (64 * j + F.lane) * 8; float f[8]; unpack8(*(const GAS v4u*)(xb + (size_t)m * DM + c0), f);
            const f32x4 g0 = *(const GAS f32x4*)(w + c0), g1 = *(const GAS f32x4*)(w + c0 + 4);
            GAS f32x4* o = (GAS f32x4*)(out + (size_t)m * DM + c0);
            o[0] = (f32x4){f[0] * rstd * g0.x, f[1] * rstd * g0.y, f[2] * rstd * g0.z, f[3] * rstd * g0.w};
            o[1] = (f32x4){f[4] * rstd * g1.x, f[5] * rstd * g1.y, f[6] * rstd * g1.z, f[7] * rstd * g1.w}; }
    }
}

struct EpiBf16Scale {
    static constexpr bool PERM = true, AFTER_DRAIN = false;
    bf16* O; int ldc; const ssq_t* ss;
    __device__ __forceinline__ void operator()(const pg8::f32x4 (&acc)[2][2][4][2], const pg8::Unit& u, int wr, int wc, int fr, int fq) const {
        const int row0 = u.pm * 256 + wr * 64 + fr; const int col0 = u.pn * 256 + wc * 32 + 8 * fq;
#pragma unroll
        for (int ai = 0; ai < 2; ++ai)
#pragma unroll
            for (int m = 0; m < 4; ++m) { const int row = row0 + ai * 128 + m * 16; bf16* rowp = O + (size_t)row * ldc + col0;
                const float rstd = __builtin_amdgcn_rsqf(ss_unpack(ss[row]) * (1.f / DM) + NORM_EPS);
#pragma unroll
                for (int bj = 0; bj < 2; ++bj) { const pg8::f32x4 v0 = acc[ai][bj][m][0] * rstd, v1 = acc[ai][bj][m][1] * rstd;
                    v4u w; w.x = pg8::cvt_pk_bf16(v0[0], v0[1]); w.y = pg8::cvt_pk_bf16(v0[2], v0[3]); w.z = pg8::cvt_pk_bf16(v1[0], v1[1]); w.w = pg8::cvt_pk_bf16(v1[2], v1[3]);
                    *(v4u*)(rowp + bj * 128) = w; } }
    }
};
struct EpiResNorm {
    static constexpr bool PERM = true, AFTER_DRAIN = false;
    const bf16* Xin; bf16* XB; ssq_t* ss; int ldc;
    __device__ __forceinline__ void operator()(const pg8::f32x4 (&acc)[2][2][4][2], const pg8::Unit& u, int wr, int wc, int fr, int fq) const {
        const int row0 = u.pm * 256 + wr * 64 + fr; const int col0 = u.pn * 256 + wc * 32 + 8 * fq;
#pragma unroll
        for (int ai = 0; ai < 2; ++ai)
#pragma unroll
            for (int m = 0; m < 4; ++m) { const int row = row0 + ai * 128 + m * 16; const size_t off = (size_t)row * ldc + col0; float sq = 0.f;
#pragma unroll
                for (int bj = 0; bj < 2; ++bj) { pg8::f32x4 x0, x1;
                    { float f[8]; unpack8(*(const v4u*)(Xin + off + bj * 128), f); x0 = (pg8::f32x4){f[0], f[1], f[2], f[3]}; x1 = (pg8::f32x4){f[4], f[5], f[6], f[7]}; }
                    const pg8::f32x4 v0 = x0 + acc[ai][bj][m][0], v1 = x1 + acc[ai][bj][m][1];
                    v4u w; w.x = pg8::cvt_pk_bf16(v0[0], v0[1]); w.y = pg8::cvt_pk_bf16(v0[2], v0[3]); w.z = pg8::cvt_pk_bf16(v1[0], v1[1]); w.w = pg8::cvt_pk_bf16(v1[2], v1[3]);
                    *(v4u*)(XB + off + bj * 128) = w;
                    sq += (v0[0] * v0[0] + v0[1] * v0[1]) + (v0[2] * v0[2] + v0[3] * v0[3]) + (v1[0] * v1[0] + v1[1] * v1[1]) + (v1[2] * v1[2] + v1[3] * v1[3]); }
                sq += swz_xor<16>(sq); { auto rr = __builtin_amdgcn_permlane32_swap(__float_as_uint(sq), __float_as_uint(sq), false, false); sq = __uint_as_float(rr[0]) + __uint_as_float(rr[1]); }
                if (fq == 0) atomicAdd(ss + row, ss_pack(sq));
                if (m & 1) asm volatile("" ::: "memory"); }
    }
};

__device__ __forceinline__ float dpp_ror1(float v)  { return __int_as_float(__builtin_amdgcn_update_dpp(0, __float_as_int(v), 0x121, 0xf, 0xf, true)); }
__device__ __forceinline__ float dpp_ror15(float v) { return __int_as_float(__builtin_amdgcn_update_dpp(0, __float_as_int(v), 0x12f, 0xf, 0xf, true)); }
__device__ __forceinline__ float dpp_shr1(float old, float v) { return __int_as_float(__builtin_amdgcn_update_dpp(__float_as_int(old), __float_as_int(v), 0x111, 0xf, 0xf, false)); }
__device__ __forceinline__ float dpp_shl1(float old, float v) { return __int_as_float(__builtin_amdgcn_update_dpp(__float_as_int(old), __float_as_int(v), 0x101, 0xf, 0xf, false)); }
__device__ __forceinline__ float gelu_tanh_fast(float x) { const float arg = x * fmaf(x * x, -0.102943239f, -2.302208198f); return x * __builtin_amdgcn_rcpf(1.f + __builtin_amdgcn_exp2f(arg)); }
constexpr int HALO_OFF = 131072;
struct EpiUpConv {
    static constexpr bool PERM = true, AFTER_DRAIN = false;
    bf16* ACT; const ssq_t* ss; const float* cw; const float* cb; float* EP; float* EA; float* EG; LAS unsigned char* lds;
    __device__ __forceinline__ void operator()(pg8::f32x4 (&acc)[2][2][4][2], const pg8::Unit& u, int wr, int wc, int fr, int fq) const {
        const int row0 = u.pm * 256 + wr * 64 + fr; const int ch0 = u.pn * 128 + wc * 32 + 8 * fq;
        LAS float* H = (LAS float*)(lds + HALO_OFF);
#pragma unroll
        for (int ai = 0; ai < 2; ++ai)
#pragma unroll
            for (int m = 0; m < 4; ++m) { const float rstd = __builtin_amdgcn_rsqf(ss_unpack(ss[row0 + ai * 128 + m * 16]) * (1.f / DM) + NORM_EPS);
#pragma unroll
                for (int bj = 0; bj < 2; ++bj)
#pragma unroll
                    for (int n = 0; n < 2; ++n) acc[ai][bj][m][n] *= rstd; }
#pragma unroll
        for (int ai = 0; ai < 2; ++ai) { const int sl = 2 * ai + wr; LAS float* hp = H + (sl * 2) * 128 + wc * 32 + 8 * fq;
            if (fr == 0) { *(LAS pg8::f32x4*)(hp) = acc[ai][1][0][0]; *(LAS pg8::f32x4*)(hp + 4) = acc[ai][1][0][1]; }
            if (fr == 15) { *(LAS pg8::f32x4*)(hp + 128) = acc[ai][1][3][0]; *(LAS pg8::f32x4*)(hp + 128 + 4) = acc[ai][1][3][1]; } }
        asm volatile("s_waitcnt lgkmcnt(0)" ::: "memory"); __builtin_amdgcn_s_barrier(); asm volatile("" ::: "memory");
        const pg8::f32x4 zero4 = (pg8::f32x4){0.f, 0.f, 0.f, 0.f};
        pg8::f32x4 w0[2], w1[2], w2[2], bb[2];
#pragma unroll
        for (int n = 0; n < 2; ++n) { w0[n] = *(const pg8::f32x4*)(cw + ch0 + 4 * n); w1[n] = *(const pg8::f32x4*)(cw + DFF + ch0 + 4 * n); w2[n] = *(const pg8::f32x4*)(cw + 2 * DFF + ch0 + 4 * n); bb[n] = *(const pg8::f32x4*)(cb + ch0 + 4 * n); }
#pragma unroll
        for (int ai = 0; ai < 2; ++ai) { const int sl = 2 * ai + wr;
            pg8::f32x4 hu[2], hd[2];
#pragma unroll
            for (int n = 0; n < 2; ++n) { hu[n] = sl > 0 ? *(const LAS pg8::f32x4*)(H + ((sl - 1) * 2 + 1) * 128 + wc * 32 + 8 * fq + 4 * n) : zero4;
                                          hd[n] = sl < 3 ? *(const LAS pg8::f32x4*)(H + ((sl + 1) * 2) * 128 + wc * 32 + 8 * fq + 4 * n) : zero4; }
#pragma unroll
            for (int m = 0; m < 4; ++m) { const int row = row0 + ai * 128 + m * 16; float o[8]; float gcv[8];
#pragma unroll
                for (int n = 0; n < 2; ++n)
#pragma unroll
                    for (int e = 0; e < 4; ++e) { const float gv = acc[ai][1][m][n][e];
                        const float xu = (fr == 15) ? (m > 0 ? acc[ai][1][m > 0 ? m - 1 : 0][n][e] : hu[n][e]) : gv;
                        const float xd = (fr == 0) ? (m < 3 ? acc[ai][1][m < 3 ? m + 1 : 3][n][e] : hd[n][e]) : gv;
                        float gc = fmaf(w1[n][e], gv, bb[n][e]);
                        gc = fmaf(dpp_ror1(xu), w0[n][e], gc);
                        gc = fmaf(dpp_ror15(xd), w2[n][e], gc);
                        gcv[4 * n + e] = gc; }
#pragma unroll
                for (int k2 = 0; k2 < 4; ++k2) { typedef float f32x2v __attribute__((ext_vector_type(2)));
                    const f32x2v x = (f32x2v){gcv[2 * k2], gcv[2 * k2 + 1]}, av = (f32x2v){acc[ai][0][m][k2 >> 1][2 * (k2 & 1)], acc[ai][0][m][k2 >> 1][2 * (k2 & 1) + 1]};
                    const f32x2v arg = x * (x * x * (f32x2v){-0.102943239f, -0.102943239f} + (f32x2v){-2.302208198f, -2.302208198f});
                    const f32x2v dn = (f32x2v){__builtin_amdgcn_exp2f(arg.x), __builtin_amdgcn_exp2f(arg.y)} + (f32x2v){1.f, 1.f};
                    const f32x2v r = (x * av) * (f32x2v){__builtin_amdgcn_rcpf(dn.x), __builtin_amdgcn_rcpf(dn.y)};
                    o[2 * k2] = r.x; o[2 * k2 + 1] = r.y; }
                const bool etop = (sl == 0 && m == 0 && fr == 0), ebot = (sl == 3 && m == 3 && fr == 15);
                if (etop || ebot) { const size_t eo = ((size_t)u.pm * 2 + (ebot ? 1 : 0)) * DFF + ch0;
#pragma unroll
                    for (int n = 0; n < 2; ++n) { *(pg8::f32x4*)(EP + eo + 4 * n) = (pg8::f32x4){gcv[4 * n], gcv[4 * n + 1], gcv[4 * n + 2], gcv[4 * n + 3]};
                        *(pg8::f32x4*)(EA + eo + 4 * n) = acc[ai][0][m][n]; *(pg8::f32x4*)(EG + eo + 4 * n) = acc[ai][1][m][n]; }
                } else { v4u w; w.x = pg8::cvt_pk_bf16(o[0], o[1]); w.y = pg8::cvt_pk_bf16(o[2], o[3]); w.z = pg8::cvt_pk_bf16(o[4], o[5]); w.w = pg8::cvt_pk_bf16(o[6], o[7]);
                    *(v4u*)(ACT + (size_t)row * DFF + ch0) = w; }
            }
        }
    }
};
__device__ __forceinline__ void ffn_edge_fixup_panel(Frame& F, bf16* ACT, const float* EP, const float* EA, const float* EG, const float* cw, int S, int pm) {
    constexpr int NC4 = DFF / 4;
    for (int it = F.tid; it < 2 * NC4; it += NTHREADS) {
        const int c4 = (it % NC4) * 4, tbq = it / NC4;
        const int row = pm * 256 + (tbq ? 255 : 0);
        const size_t eo = ((size_t)pm * 2 + tbq) * DFF + c4;
        f32x4 gp = *(const f32x4*)(EP + eo); const f32x4 av = *(const f32x4*)(EA + eo);
        if (tbq == 0) { if (row % S != 0) { const f32x4 gn = *(const f32x4*)(EG + ((size_t)(pm - 1) * 2 + 1) * DFF + c4), w = *(const f32x4*)(cw + c4); gp = gp + gn * w; } }
        else { if ((row + 1) % S != 0) { const f32x4 gn = *(const f32x4*)(EG + ((size_t)(pm + 1) * 2) * DFF + c4), w = *(const f32x4*)(cw + 2 * DFF + c4); gp = gp + gn * w; } }
        const unsigned lo = pg8::cvt_pk_bf16(gelu_tanh_fast(gp.x) * av.x, gelu_tanh_fast(gp.y) * av.y), hi = pg8::cvt_pk_bf16(gelu_tanh_fast(gp.z) * av.z, gelu_tanh_fast(gp.w) * av.w);
        *(unsigned long long*)(ACT + (size_t)row * DFF + c4) = (unsigned long long)lo | ((unsigned long long)hi << 32);
    }
}
typedef short bf16x8 __attribute__((ext_vector_type(8)));
typedef float f32x16 __attribute__((ext_vector_type(16)));
typedef short s16x4 __attribute__((ext_vector_type(4)));
typedef short v4i16_t __attribute__((ext_vector_type(4)));
__device__ __forceinline__ unsigned cvtpk(float lo, float hi) { unsigned r; asm("v_cvt_pk_bf16_f32 %0, %1, %2" : "=v"(r) : "v"(lo), "v"(hi)); return r; }
__device__ __forceinline__ float half_max(float v) { auto rr = __builtin_amdgcn_permlane32_swap(__float_as_uint(v), __float_as_uint(v), false, false); return fmaxf(__uint_as_float(rr[0]), __uint_as_float(rr[1])); }
__device__ __forceinline__ float half_sum(float v) { auto rr = __builtin_amdgcn_permlane32_swap(__float_as_uint(v), __float_as_uint(v), false, false); return __uint_as_float(rr[0]) + __uint_as_float(rr[1]); }
#define TR_READ(dst, addr, imm) asm volatile("ds_read_b64_tr_b16 %0, %1 offset:%c2" : "=&v"(dst) : "v"(addr), "i"(imm) : "memory")
#define LGKM_WAIT(n) asm volatile("s_waitcnt lgkmcnt(" #n ")" ::: "memory")
#define VFRAG(lo, hi) ((bf16x8){(lo)[0], (lo)[1], (lo)[2], (lo)[3], (hi)[0], (hi)[1], (hi)[2], (hi)[3]})

constexpr int DF_KMAP = 8192, DF_V = 16384, DF_BUF = 32768;
constexpr int DF_Q = 2 * DF_BUF, DF_QROW = 272;
static_assert(DF_Q + 8 * 32 * DF_QROW <= RING_BYTES, "diff attention LDS");
__device__ __forceinline__ void diff_mfma(Frame& F, const bf16* proj, bf16* mix, const float* nw, float lam, float lam_init, int S, int nseq, unsigned* qctr) {
    frame_refresh(F);
    const int lane = F.lane, wave = F.wave, q32 = lane & 31, hh = lane >> 5;
    LAS unsigned char* L = F.lds + RING_OFF;
    const int nqb = S / 256, nunits = nseq * DIFF_H * nqb, NT = S / 64;
    const unsigned kaddr0 = (unsigned)(q32 * 128 + (((((q32 >> 1) & 7) >> 1) << 1 | (hh ^ ((q32 >> 1) & 1))) * 16));
    const int i16 = lane & 15, q4 = i16 >> 2, p4 = i16 & 3, g1 = (lane >> 4) & 1;
    const unsigned trlo = (unsigned)(DF_V + 64 * (4 * hh + q4) + 16 * ((2 * g1 + (p4 >> 1)) ^ hh) + 8 * (p4 & 1));
    const unsigned trhi = (unsigned)(DF_V + 2048 + 64 * (4 * hh + q4) + 16 * ((2 * g1 + (p4 >> 1)) ^ ((2 + hh) & 3)) + 8 * (p4 & 1));
    const float sc2 = 0.125f * LOG2E;
#define DF_STAGE(buf, tile) do { const bf16* k0_ = kg + (size_t)(tile) * 64 * DIN; const bf16* k1_ = k0_ + 64; const bf16* v0_ = vg + (size_t)(tile) * 64 * DIN; const bf16* v1_ = v0_ + 32 * DIN; \
        unsigned ko_ = kgoffB, vo_ = vgoffB; asm volatile("" : "+s"(k0_), "+s"(k1_), "+s"(v0_), "+s"(v1_), "+v"(ko_), "+v"(vo_)); \
        LAS unsigned char* Bw_ = L + (buf) * DF_BUF + wave * 1024; \
        __builtin_amdgcn_global_load_lds((const unsigned*)((const char*)k0_ + ko_), (LAS unsigned*)(Bw_), 16, 0, 0); \
        __builtin_amdgcn_global_load_lds((const unsigned*)((const char*)k1_ + ko_), (LAS unsigned*)(Bw_ + DF_KMAP), 16, 0, 0); \
        __builtin_amdgcn_global_load_lds((const unsigned*)((const char*)v0_ + vo_), (LAS unsigned*)(Bw_ + DF_V), 16, 0, 0); \
        __builtin_amdgcn_global_load_lds((const unsigned*)((const char*)v1_ + vo_), (LAS unsigned*)(Bw_ + DF_V + 8192), 16, 0, 0); } while (0)
    for (;;) {
        const int lane_u = lane_id_now();
        const int it = q_next(qctr, (volatile LAS int*)(F.lds + MISC_OFF + 64), wave, lane_u); if (it >= nunits) break;
        const int qb = it % nqb, h = (it / nqb) % DIFF_H, s = it / (nqb * DIFF_H);
        const int row0 = s * S;
        const float nslope2 = __uint_as_float(__builtin_amdgcn_readfirstlane(__float_as_uint(-exp2f(-8.f * (float)(h + 1) / 6.f) * LOG2E)));
        const int ih = qb * 256 + wave * 32 + (lane_u & 31) - 4 * (lane_u >> 5);
        const int td = (qb * 256 + wave * 32) >> 6;
        const int kkey = 8 * wave + (lane_u >> 3);
        const unsigned kgoffB = (unsigned)(kkey * DIN + ((lane_u & 7) ^ ((kkey >> 1) & 7)) * 8) * 2u;
        unsigned vgoffB;
        { const int pv = wave, rowhi = pv >> 1, chhi = 2 * (pv & 1) + (lane_u >> 5), r7 = (lane_u & 31) >> 2, slot = lane_u & 3;
          const int x = (2 * (rowhi & 1) + (r7 >> 2)) & 3, ch = 4 * chhi + (slot ^ x), row = 8 * rowhi + r7; vgoffB = (unsigned)(row * DIN + ch * 8) * 2u; }
        const bf16* kg = proj + (size_t)row0 * DIN + C_DK + h * 128;
        const bf16* vg = proj + (size_t)row0 * DIN + C_DV + h * 128;
        DF_STAGE(0, 0);
        bf16x8 qf[2][4];
        { const bf16* qp = proj + (size_t)(row0 + qb * 256 + wave * 32 + (lane_u & 31)) * DIN + C_DQ + h * 128 + (lane_u >> 5) * 8;
#pragma unroll
          for (int c = 0; c < 2; ++c)
#pragma unroll
              for (int ds = 0; ds < 4; ++ds) { float f[8]; unpack8(*(const v4u*)(qp + c * 64 + ds * 16), f);
                  v4u w; w.x = cvtpk(f[0] * sc2, f[1] * sc2); w.y = cvtpk(f[2] * sc2, f[3] * sc2); w.z = cvtpk(f[4] * sc2, f[5] * sc2); w.w = cvtpk(f[6] * sc2, f[7] * sc2);
                  qf[c][ds] = __builtin_bit_cast(bf16x8, w); } }
        const unsigned tra_lo = (unsigned)(uintptr_t)L + trlo, tra_hi = (unsigned)(uintptr_t)L + trhi;
        f32x16 O[2][4];
#pragma unroll
        for (int c = 0; c < 2; ++c)
#pragma unroll
            for (int db = 0; db < 4; ++db)
#pragma unroll
                for (int r = 0; r < 16; ++r) O[c][db][r] = 0.f;
        float m = 0.f, l[2] = {0.f, 0.f};
        asm volatile("s_waitcnt vmcnt(0)" ::: "memory");
        __syncthreads();
#pragma unroll 1
        for (int t2 = 0; t2 < NT; t2 += 2) {
#pragma unroll
          for (int tb_ = 0; tb_ < 2; ++tb_) {
            const int t = t2 + tb_;
            const LAS unsigned char* B = L + tb_ * DF_BUF;
            if (t + 1 < NT) DF_STAGE(tb_ ^ 1, t + 1);
            const float nsS = __uint_as_float(__builtin_amdgcn_readfirstlane(__float_as_uint(t < td ? nslope2 : -nslope2)));
            const float ns8 = __uint_as_float(__builtin_amdgcn_readfirstlane(__float_as_uint(8.f * nsS)));
#pragma unroll
            for (int kb = 0; kb < 2; ++kb) {
                bf16x8 kf[2][4];
#pragma unroll
                for (int c = 0; c < 2; ++c)
#pragma unroll
                    for (int ds = 0; ds < 4; ++ds) kf[c][ds] = *(const LAS bf16x8*)(B + c * DF_KMAP + kb * 4096 + (kaddr0 ^ (unsigned)(ds << 5)));
                __builtin_amdgcn_sched_barrier(0);
                f32x16 bias;
                float tbk = (float)(ih - t * 64 - 32 * kb); asm volatile("" : "+v"(tbk));
                if (__builtin_expect(t != td, 1)) {
                    const float b0 = __builtin_fmaf(tbk, nsS, -m);
                    bias[0] = b0; bias[4] = b0 - ns8; bias[8] = __builtin_fmaf(-2.f, ns8, b0); bias[12] = bias[8] - ns8;
#pragma unroll
                    for (int j = 0; j < 4; ++j) { bias[4 * j + 1] = bias[4 * j] - nsS; bias[4 * j + 2] = __builtin_fmaf(-2.f, nsS, bias[4 * j]); bias[4 * j + 3] = __builtin_fmaf(-2.f, nsS, bias[4 * j + 1]); }
                } else {
#pragma unroll
                    for (int r = 0; r < 16; ++r) bias[r] = __builtin_fmaf(__builtin_fabsf(tbk - (float)((r & 3) + 8 * (r >> 2))), nslope2, -m);
                }
                __builtin_amdgcn_sched_barrier(0);
                f32x16 a[2];
#pragma unroll
                for (int c = 0; c < 2; ++c)
#pragma unroll
                    for (int ds = 0; ds < 4; ++ds) a[c] = __builtin_amdgcn_mfma_f32_32x32x16_bf16(kf[c][ds], qf[c][ds], ds == 0 ? bias : a[c], 0, 0, 0);
                s16x4 vl[4][2], vh[4][2];
#define DF_VREQ(db) do { _Pragma("unroll") for (int sI = 0; sI < 2; ++sI) { TR_READ(vl[db][sI], tra_lo, tb_ * DF_BUF + 4096 * (2 * kb + sI) + 512 * (db)); TR_READ(vh[db][sI], tra_hi, tb_ * DF_BUF + 4096 * (2 * kb + sI) + 512 * (db)); } } while (0)
#define DF_PV(db) do { _Pragma("unroll") for (int sI = 0; sI < 2; ++sI) { const bf16x8 vf = VFRAG(vl[db][sI], vh[db][sI]); \
                        O[0][db] = __builtin_amdgcn_mfma_f32_32x32x16_bf16(vf, pf[0][sI], O[0][db], 0, 0, 0); O[1][db] = __builtin_amdgcn_mfma_f32_32x32x16_bf16(vf, pf[1][sI], O[1][db], 0, 0, 0); } } while (0)
                __builtin_amdgcn_sched_barrier(0);
                DF_VREQ(0); DF_VREQ(1);
                bf16x8 pf[2][2];
                float ls[2] = {0.f, 0.f};
#pragma unroll
                for (int c = 0; c < 2; ++c)
#pragma unroll
                    for (int r = 0; r < 16; ++r) { const float p = __builtin_amdgcn_exp2f(a[c][r]); ls[c] += p; a[c][r] = p; }
                if (__builtin_expect(__any(fmaxf(ls[0], ls[1]) > 65536.f), 0)) {
                    const float lm = fmaxf(ls[0], ls[1]);
                    const int e_ = __builtin_amdgcn_frexp_expf(lm) - 1; const float dl = half_max((float)(e_ > 0 ? e_ : 0)), alpha = __builtin_amdgcn_exp2f(-dl);
                    m += dl;
#pragma unroll
                    for (int c = 0; c < 2; ++c) { l[c] *= alpha; ls[c] *= alpha;
#pragma unroll
                        for (int r = 0; r < 16; ++r) { float x_ = a[c][r]; mul_inplace(x_, alpha); a[c][r] = x_; }
#pragma unroll
                        for (int db = 0; db < 4; ++db)
#pragma unroll
                            for (int r = 0; r < 16; ++r) { float x_ = O[c][db][r]; mul_inplace(x_, alpha); O[c][db][r] = x_; } } }
#pragma unroll
                for (int c = 0; c < 2; ++c) { l[c] += ls[c];
#pragma unroll
                    for (int sI = 0; sI < 2; ++sI) { v4u w; w.x = cvtpk(a[c][8 * sI], a[c][8 * sI + 1]); w.y = cvtpk(a[c][8 * sI + 2], a[c][8 * sI + 3]); w.z = cvtpk(a[c][8 * sI + 4], a[c][8 * sI + 5]); w.w = cvtpk(a[c][8 * sI + 6], a[c][8 * sI + 7]);
                        pf[c][sI] = __builtin_bit_cast(bf16x8, w); }
                }
                __builtin_amdgcn_sched_barrier(0);
                LGKM_WAIT(4); __builtin_amdgcn_sched_barrier(0);
                DF_VREQ(2); __builtin_amdgcn_sched_barrier(0);
                DF_PV(0);   __builtin_amdgcn_sched_barrier(0);
                LGKM_WAIT(4); __builtin_amdgcn_sched_barrier(0);
                DF_VREQ(3); __builtin_amdgcn_sched_barrier(0);
                DF_PV(1);   __builtin_amdgcn_sched_barrier(0);
                LGKM_WAIT(4); __builtin_amdgcn_sched_barrier(0);
                DF_PV(2);   __builtin_amdgcn_sched_barrier(0);
                LGKM_WAIT(0); __builtin_amdgcn_sched_barrier(0);
                DF_PV(3);   __builtin_amdgcn_sched_barrier(0);
#undef DF_VREQ
#undef DF_PV
            }
            asm volatile("s_waitcnt vmcnt(0) lgkmcnt(0)" ::: "memory");
            __builtin_amdgcn_s_barrier(); asm volatile("" ::: "memory");
          }
        }
        const float inv0 = 1.f / half_sum(l[0]), inv1 = lam / half_sum(l[1]);
        float ss = 0.f;
#pragma unroll
        for (int db = 0; db < 4; ++db)
#pragma unroll
            for (int r = 0; r < 16; ++r) { const float o = O[0][db][r] * inv0 - O[1][db][r] * inv1; O[0][db][r] = o; ss += o * o; }
        ss = half_sum(ss);
        float li_ = __uint_as_float(__builtin_amdgcn_readfirstlane(__float_as_uint(lam_init))); asm volatile("" : "+s"(li_));
        const float rn = (1.f - li_) / sqrtf(ss * (1.f / 128.f) + NORM_EPS);
        const int lane_e = lane_id_now();
        const int hh_u = lane_e >> 5, i_u = qb * 256 + wave * 32 + (lane_e & 31);
        bf16* op = mix + (size_t)(row0 + i_u) * DM + MIX_DIFF + h * 128; const float* wp = nw + h * 128 + 4 * hh_u;
#pragma unroll
        for (int db = 0; db < 4; ++db)
#pragma unroll
            for (int rp = 0; rp < 2; ++rp) { unsigned w[2][2];
#pragma unroll
                for (int q_ = 0; q_ < 2; ++q_) { const int rg = 2 * rp + q_; const f32x4 g = *(const f32x4*)(wp + 32 * db + 8 * rg);
                    w[q_][0] = cvtpk(O[0][db][4 * rg] * rn * g.x, O[0][db][4 * rg + 1] * rn * g.y); w[q_][1] = cvtpk(O[0][db][4 * rg + 2] * rn * g.z, O[0][db][4 * rg + 3] * rn * g.w); }
                store_pair16(op + 32 * db + 16 * rp, hh_u, w[0][0], w[0][1], w[1][0], w[1][1]); }
    }
#undef DF_STAGE
}

constexpr int RT_V = 8192, RT_BUF = 16384, RT_NBUF = 4, RT_Q = RT_NBUF * RT_BUF, RT_QROW = 144;
constexpr int RT_SX = RT_Q + 8 * 32 * RT_QROW;
static_assert(RT_SX + 16384 + 64 * 144 <= RING_BYTES, "retention LDS");
__device__ __forceinline__ void ret_mfma(Frame& F, const bf16* proj, bf16* mix, const float* dec_f, const float* dec_b, const float* nw, int S, int nseq, unsigned* qctr) {
    frame_refresh(F);
    const int lane = F.lane, wave = F.wave, q32 = lane & 31, hh = lane >> 5;
    LAS unsigned char* L = F.lds + RING_OFF;
    const int nqb = S / 256, nunits = nseq * RET_H * nqb, NT = S / 64;
    const int kkey = 8 * wave + (lane >> 3);
    const unsigned kgoff = (unsigned)(kkey * DIN + ((lane & 7) ^ ((kkey >> 1) & 7)) * 8);
    unsigned vgoff;
    { const int chq = lane >> 5, r7 = (lane & 31) >> 2, slot = lane & 3, x = (2 * (wave & 1) + (r7 >> 2)) & 3; vgoff = (unsigned)((8 * wave + r7) * DIN + (4 * chq + (slot ^ x)) * 8); }
    const unsigned kaddr0 = (unsigned)(q32 * 128 + (((((q32 >> 1) & 7) >> 1) << 1 | (hh ^ ((q32 >> 1) & 1))) * 16));
    const int i16 = lane & 15, q4 = i16 >> 2, p4 = i16 & 3, g1 = (lane >> 4) & 1;
    const unsigned trlo = (unsigned)(RT_V + 64 * (4 * hh + q4) + 16 * ((2 * g1 + (p4 >> 1)) ^ hh) + 8 * (p4 & 1));
    const unsigned trhi = (unsigned)(RT_V + 1024 + 64 * (4 * hh + q4) + 16 * ((2 * g1 + (p4 >> 1)) ^ ((2 + hh) & 3)) + 8 * (p4 & 1));
#define RT_STAGE(buf, tile) do { const size_t go_ = (size_t)(tile) * 64 * DIN; LAS unsigned char* Bw_ = L + (buf) * RT_BUF + wave * 1024; \
        __builtin_amdgcn_global_load_lds((const unsigned*)(kg + go_ + kgoff), (LAS unsigned*)(Bw_), 16, 0, 0); \
        __builtin_amdgcn_global_load_lds((const unsigned*)(vg + go_ + vgoff), (LAS unsigned*)(Bw_ + RT_V), 16, 0, 0); } while (0)
    for (;;) {
        const int it = q_next(qctr, (volatile LAS int*)(F.lds + MISC_OFF + 64), wave, lane); if (it >= nunits) break;
        const int qb = it % nqb, h = (it / nqb) % RET_H, s = it / (nqb * RET_H);
        const int row0 = s * S, i = qb * 256 + wave * 32 + q32;
        const float lgf = __uint_as_float(__builtin_amdgcn_readfirstlane(__float_as_uint(-log2f(1.f + expf(-dec_f[h])))));
        const float lgb = __uint_as_float(__builtin_amdgcn_readfirstlane(__float_as_uint(-log2f(1.f + expf(-dec_b[h])))));
        int lane_u = lane; asm volatile("" : "+v"(lane_u));
        const bf16* kg = proj + (size_t)row0 * DIN + C_RK + h * 64;
        const bf16* vg = proj + (size_t)row0 * DIN + C_RV + h * 64;
        { const int nL_ = 4 * qb; const int t0 = (0 < nL_ + 4 ? 0 : NT - 1 - (0 - nL_ - 4)), t1 = (1 < nL_ + 4 ? 1 : NT - 1 - (1 - nL_ - 4)), t2 = (2 < nL_ + 4 ? 2 : NT - 1 - (2 - nL_ - 4));
          RT_STAGE(0, t0); RT_STAGE(1, t1); RT_STAGE(2, t2); }
        { LAS unsigned char* Qw = L + RT_Q + wave * (32 * RT_QROW);
#pragma unroll
          for (int k = 0; k < 4; ++k) { const int idx = k * 64 + lane_u, qrow = idx >> 3, qch = idx & 7; float f[8];
              unpack8(*(const v4u*)(proj + (size_t)(row0 + qb * 256 + wave * 32 + qrow) * DIN + C_RQ + h * 64 + qch * 8), f);
              v4u w; w.x = cvtpk(f[0] * 0.125f, f[1] * 0.125f); w.y = cvtpk(f[2] * 0.125f, f[3] * 0.125f); w.z = cvtpk(f[4] * 0.125f, f[5] * 0.125f); w.w = cvtpk(f[6] * 0.125f, f[7] * 0.125f);
              *(LAS v4u*)(Qw + qrow * RT_QROW + qch * 16) = w; } }
        const LAS unsigned char* Qr = L + RT_Q + wave * (32 * RT_QROW) + q32 * RT_QROW + hh * 16;
        const unsigned tra_lo = (unsigned)(uintptr_t)L + trlo, tra_hi = (unsigned)(uintptr_t)L + trhi;
        const int nL = 4 * qb, nSteps = NT;
#define RT_TILE_OF(st) ((st) < nL + 4 ? (st) : (NT - 1 - ((st) - nL - 4)))
        f32x16 O[2], St;
#pragma unroll
        for (int r = 0; r < 16; ++r) { O[0][r] = 0.f; O[1][r] = 0.f; St[r] = 0.f; }
        int lx = lane_u; asm volatile("" : "+v"(lx));
        const int hhx = lx >> 5, q4x = (lx & 15) >> 2, p4x = lx & 3, g1x = (lx >> 4) & 1;
        const int bd = wave & 1, be = (wave >> 1) & 1, kh = wave >> 2;
        const unsigned ka_lo = (unsigned)(uintptr_t)L + (unsigned)((4 * hhx + q4x) * 128 + (((4 * bd + 2 * g1x + (p4x >> 1)) ^ ((2 * hhx + (q4x >> 1)) & 7)) * 16) + 8 * (p4x & 1));
        const unsigned ka_hi = (unsigned)(uintptr_t)L + (unsigned)((8 + 4 * hhx + q4x) * 128 + (((4 * bd + 2 * g1x + (p4x >> 1)) ^ ((4 + 2 * hhx + (q4x >> 1)) & 7)) * 16) + 8 * (p4x & 1));
        float kfs[2][8];
#pragma unroll
        for (int sx = 0; sx < 2; ++sx)
#pragma unroll
            for (int j = 0; j < 8; ++j) kfs[sx][j] = __builtin_amdgcn_exp2f(lgf * (float)(63 - (16 * (2 * kh + sx) + (j < 4 ? 4 * hhx + j : 8 + 4 * hhx + (j - 4)))));
        const float gf64 = __builtin_amdgcn_exp2f(lgf * 64.f), gb64 = __builtin_amdgcn_exp2f(lgb * 64.f);
        const int iloc = wave * 32 + (lx & 31);
        LAS float* SXF = (LAS float*)(L + RT_SX);
        LAS unsigned char* SXB = L + RT_SX + 16384;
#define RT_SIDE_DONE(rowfac) do { \
            asm volatile("s_waitcnt lgkmcnt(0)" ::: "memory"); __builtin_amdgcn_s_barrier(); asm volatile("" ::: "memory"); \
            if (kh == 1) { _Pragma("unroll") for (int r = 0; r < 16; ++r) SXF[((wave & 3) * 16 + r) * 64 + lx] = St[r]; } \
            asm volatile("s_waitcnt lgkmcnt(0)" ::: "memory"); __builtin_amdgcn_s_barrier(); asm volatile("" ::: "memory"); \
            if (kh == 0) { _Pragma("unroll") for (int rg = 0; rg < 4; ++rg) { float v_[4]; \
                    _Pragma("unroll") for (int e_ = 0; e_ < 4; ++e_) v_[e_] = St[4 * rg + e_] + SXF[((wave & 3) * 16 + 4 * rg + e_) * 64 + lx]; \
                    *(LAS unsigned long long*)(SXB + (32 * be + (lx & 31)) * 144 + (32 * bd + 8 * rg + 4 * hhx) * 2) = (unsigned long long)cvtpk(v_[0], v_[1]) | ((unsigned long long)cvtpk(v_[2], v_[3]) << 32); } } \
            asm volatile("s_waitcnt lgkmcnt(0)" ::: "memory"); __builtin_amdgcn_s_barrier(); asm volatile("" ::: "memory"); \
            { f32x16 x0, x1; _Pragma("unroll") for (int r = 0; r < 16; ++r) { x0[r] = 0.f; x1[r] = 0.f; } \
              _Pragma("unroll") for (int ds = 0; ds < 4; ++ds) { const bf16x8 qv = *(const LAS bf16x8*)(Qr + ds * 32); \
                  const bf16x8 s0 = *(const LAS bf16x8*)(SXB + (lx & 31) * 144 + ds * 32 + hhx * 16), s1 = *(const LAS bf16x8*)(SXB + (32 + (lx & 31)) * 144 + ds * 32 + hhx * 16); \
                  x0 = __builtin_amdgcn_mfma_f32_32x32x16_bf16(s0, qv, x0, 0, 0, 0); x1 = __builtin_amdgcn_mfma_f32_32x32x16_bf16(s1, qv, x1, 0, 0, 0); } \
              const float rf_ = (rowfac); _Pragma("unroll") for (int r = 0; r < 16; ++r) { O[0][r] += x0[r] * rf_; O[1][r] += x1[r] * rf_; St[r] = 0.f; } } \
        } while (0)
#pragma unroll 1
        for (int st = 0; st < nSteps; ++st) {
            const int t = RT_TILE_OF(st);
            const unsigned boff = (unsigned)((st & 3) * RT_BUF);
            const LAS unsigned char* B = L + boff;
            const unsigned tl = tra_lo + boff, th = tra_hi + boff;
            if (st + 2 < nSteps) asm volatile("s_waitcnt vmcnt(4)" ::: "memory"); else if (st + 1 < nSteps) asm volatile("s_waitcnt vmcnt(2)" ::: "memory"); else asm volatile("s_waitcnt vmcnt(0)" ::: "memory");
            __builtin_amdgcn_s_barrier(); asm volatile("" ::: "memory");
            if (st + 3 < nSteps) { const int tn = RT_TILE_OF(st + 3); RT_STAGE((st + 3) & 3, tn); }
            const bool diag = (st >= nL) && (st < nL + 4);
            if (st == nL) {
                RT_SIDE_DONE(__builtin_amdgcn_exp2f(lgf * (float)(iloc + 1)));
#pragma unroll
                for (int sx = 0; sx < 2; ++sx)
#pragma unroll
                    for (int j = 0; j < 8; ++j) kfs[sx][j] = __builtin_amdgcn_exp2f(lgb * (float)(16 * (2 * kh + sx) + (j < 4 ? 4 * hhx + j : 8 + 4 * hhx + (j - 4))));
            }
            if (!diag) {
                const float g64 = st < nL ? gf64 : gb64;
#pragma unroll
                for (int r = 0; r < 16; ++r) St[r] *= g64;
                s16x4 kl[2], khh[2], vl2[2], vh2[2];
                const unsigned kal = ka_lo + boff, kah = ka_hi + boff, tlb = tl + 512u * (unsigned)be, thb = th + 512u * (unsigned)be;
#pragma unroll
                for (int sx = 0; sx < 2; ++sx) { if (kh == 0) { TR_READ(kl[sx], kal, 2048 * sx); TR_READ(khh[sx], kah, 2048 * sx); TR_READ(vl2[sx], tlb, 2048 * sx); TR_READ(vh2[sx], thb, 2048 * sx); }
                                                 else         { TR_READ(kl[sx], kal, 2048 * (2 + sx)); TR_READ(khh[sx], kah, 2048 * (2 + sx)); TR_READ(vl2[sx], tlb, 2048 * (2 + sx)); TR_READ(vh2[sx], thb, 2048 * (2 + sx)); } }
                LGKM_WAIT(0); __builtin_amdgcn_sched_barrier(0);
#pragma unroll
                for (int sx = 0; sx < 2; ++sx) {
                    unsigned kw[4];
#pragma unroll
                    for (int d2 = 0; d2 < 2; ++d2) { const unsigned ulo = ((unsigned)(unsigned short)kl[sx][2 * d2]) | ((unsigned)(unsigned short)kl[sx][2 * d2 + 1] << 16), uhi = ((unsigned)(unsigned short)khh[sx][2 * d2]) | ((unsigned)(unsigned short)khh[sx][2 * d2 + 1] << 16);
                        kw[d2] = cvtpk(bflo(ulo) * kfs[sx][2 * d2], bfhi(ulo) * kfs[sx][2 * d2 + 1]); kw[2 + d2] = cvtpk(bflo(uhi) * kfs[sx][4 + 2 * d2], bfhi(uhi) * kfs[sx][4 + 2 * d2 + 1]); }
                    const bf16x8 af = __builtin_bit_cast(bf16x8, (v4u){kw[0], kw[1], kw[2], kw[3]});
                    St = __builtin_amdgcn_mfma_f32_32x32x16_bf16(af, VFRAG(vl2[sx], vh2[sx]), St, 0, 0, 0); }
            } else {
            const float tb = (float)(i - t * 64 - 4 * hh);
            {
                f32x16 a0, a1;
#pragma unroll
                for (int r = 0; r < 16; ++r) { a0[r] = 0.f; a1[r] = 0.f; }
#pragma unroll
                for (int ds = 0; ds < 4; ++ds) { const bf16x8 qv = *(const LAS bf16x8*)(Qr + ds * 32);
                    const bf16x8 k0 = *(const LAS bf16x8*)(B + (kaddr0 ^ (unsigned)(ds << 5))), k1 = *(const LAS bf16x8*)(B + 4096 + (kaddr0 ^ (unsigned)(ds << 5)));
                    a0 = __builtin_amdgcn_mfma_f32_32x32x16_bf16(k0, qv, a0, 0, 0, 0); a1 = __builtin_amdgcn_mfma_f32_32x32x16_bf16(k1, qv, a1, 0, 0, 0); }
                s16x4 vl[2][4], vh[2][4];
                __builtin_amdgcn_sched_barrier(0);
#pragma unroll
                for (int db = 0; db < 2; ++db)
#pragma unroll
                    for (int ks = 0; ks < 4; ++ks) { TR_READ(vl[db][ks], tl, 2048 * ks + 512 * db); TR_READ(vh[db][ks], th, 2048 * ks + 512 * db); }
                __builtin_amdgcn_sched_barrier(0);
#pragma unroll
                for (int r = 0; r < 16; ++r) { const float t0 = tb - (float)((r & 3) + 8 * (r >> 2)), t1 = t0 - 32.f;
                    a0[r] *= __builtin_amdgcn_exp2f(fabsf(t0) * (t0 >= 0.f ? lgf : lgb)); a1[r] *= __builtin_amdgcn_exp2f(fabsf(t1) * (t1 >= 0.f ? lgf : lgb)); }
                bf16x8 pf[4];
#pragma unroll
                for (int sI = 0; sI < 2; ++sI) { v4u w; w.x = cvtpk(a0[8 * sI], a0[8 * sI + 1]); w.y = cvtpk(a0[8 * sI + 2], a0[8 * sI + 3]); w.z = cvtpk(a0[8 * sI + 4], a0[8 * sI + 5]); w.w = cvtpk(a0[8 * sI + 6], a0[8 * sI + 7]);
                    pf[sI] = __builtin_bit_cast(bf16x8, w);
                    v4u x; x.x = cvtpk(a1[8 * sI], a1[8 * sI + 1]); x.y = cvtpk(a1[8 * sI + 2], a1[8 * sI + 3]); x.z = cvtpk(a1[8 * sI + 4], a1[8 * sI + 5]); x.w = cvtpk(a1[8 * sI + 6], a1[8 * sI + 7]);
                    pf[2 + sI] = __builtin_bit_cast(bf16x8, x); }
                __builtin_amdgcn_sched_barrier(0); LGKM_WAIT(0); __builtin_amdgcn_sched_barrier(0);
#pragma unroll
                for (int ks = 0; ks < 4; ++ks)
#pragma unroll
                    for (int db = 0; db < 2; ++db) O[db] = __builtin_amdgcn_mfma_f32_32x32x16_bf16(VFRAG(vl[db][ks], vh[db][ks]), pf[ks], O[db], 0, 0, 0);
            }
            }
            asm volatile("s_waitcnt lgkmcnt(0)" ::: "memory");
        }
        RT_SIDE_DONE(__builtin_amdgcn_exp2f(lgb * (float)(256 - iloc)));
#undef RT_SIDE_DONE
#undef RT_TILE_OF
        float sm = 0.f;
#pragma unroll
        for (int db = 0; db < 2; ++db)
#pragma unroll
            for (int r = 0; r < 16; ++r) sm += O[db][r];
        const float mean = half_sum(sm) * (1.f / 64.f); float var = 0.f;
#pragma unroll
        for (int db = 0; db < 2; ++db)
#pragma unroll
            for (int r = 0; r < 16; ++r) { O[db][r] -= mean; var += O[db][r] * O[db][r]; }
        const float rstd = 1.f / sqrtf(half_sum(var) * (1.f / 64.f) + NORM_EPS);
        const int hh_u = lane_u >> 5, i_u = qb * 256 + wave * 32 + (lane_u & 31);
        const bf16* gp = proj + (size_t)(row0 + i_u) * DIN + C_RG + h * 64 + 4 * hh_u; bf16* op = mix + (size_t)(row0 + i_u) * DM + MIX_RET + h * 64; const float* wp = nw + h * 64 + 4 * hh_u;
#pragma unroll
        for (int db = 0; db < 2; ++db)
#pragma unroll
            for (int rp = 0; rp < 2; ++rp) { unsigned w[2][2];
#pragma unroll
              for (int q_ = 0; q_ < 2; ++q_) { const int rg = 2 * rp + q_; const f32x4 gw = *(const f32x4*)(wp + 32 * db + 8 * rg); const unsigned long long gv = *(const unsigned long long*)(gp + 32 * db + 8 * rg);
                const float g0 = bflo((unsigned)gv), g1_ = bfhi((unsigned)gv), g2 = bflo((unsigned)(gv >> 32)), g3 = bfhi((unsigned)(gv >> 32));
                const float y0 = O[db][4 * rg] * rstd * gw.x * (g0 / (1.f + __expf(-g0))), y1 = O[db][4 * rg + 1] * rstd * gw.y * (g1_ / (1.f + __expf(-g1_)));
                const float y2 = O[db][4 * rg + 2] * rstd * gw.z * (g2 / (1.f + __expf(-g2))), y3 = O[db][4 * rg + 3] * rstd * gw.w * (g3 / (1.f + __expf(-g3)));
                w[q_][0] = cvtpk(y0, y1); w[q_][1] = cvtpk(y2, y3); }
              store_pair16(op + 32 * db + 16 * rp, hh_u, w[0][0], w[0][1], w[1][0], w[1][1]); }
    }
#undef RT_STAGE
}

constexpr int NA_TBL = RT_Q + 8 * 32 * RT_QROW, NA_TROW = 160;
static_assert(NA_TBL + 15 * NA_TROW * 4 <= RING_BYTES, "NA LDS");
__device__ __forceinline__ void na_mfma(Frame& F, const bf16* proj, bf16* mix, const float* rpb, int S, int nseq, unsigned* qctr) {
    frame_refresh(F);
    const int lane = F.lane, wave = F.wave, q32 = lane & 31, hh = lane >> 5;
    LAS unsigned char* L = F.lds + RING_OFF;
    const int rows = S / 64, nrq = rows / 4, nunits = nseq * NA_H * nrq;
    const int kkey = 8 * wave + (lane >> 3);
    const unsigned kgoff = (unsigned)(kkey * DIN + ((lane & 7) ^ ((kkey >> 1) & 7)) * 8);
    unsigned vgoff;
    { const int chq = lane >> 5, r7 = (lane & 31) >> 2, slot = lane & 3, x = (2 * (wave & 1) + (r7 >> 2)) & 3; vgoff = (unsigned)((8 * wave + r7) * DIN + (4 * chq + (slot ^ x)) * 8); }
    const int blk = wave & 3, rp = wave >> 2, qc = 16 * blk + (q32 & 15);
    const int cb = (16 * blk - 8) < 0 ? 0 : ((16 * blk - 8) > 32 ? 32 : (16 * blk - 8));
    const int cs = (qc - 8) < 0 ? 0 : ((qc - 8) > 48 ? 48 : (qc - 8));
    const int kcol = cb + q32;
    const unsigned kaddr0 = (unsigned)(kcol * 128 + (((((kcol >> 1) & 7) >> 1) << 1 | (hh ^ ((kcol >> 1) & 1))) * 16));
    const int i16 = lane & 15, q4 = i16 >> 2, p4 = i16 & 3, g1 = (lane >> 4) & 1, pc0 = cb >> 3;
    const unsigned trlo = (unsigned)(RT_V + pc0 * 1024 + 64 * (4 * hh + q4) + 16 * ((2 * g1 + (p4 >> 1)) ^ ((2 * (pc0 & 1) + hh) & 3)) + 8 * (p4 & 1));
    const unsigned trhi = (unsigned)(RT_V + (pc0 + 1) * 1024 + 64 * (4 * hh + q4) + 16 * ((2 * g1 + (p4 >> 1)) ^ ((2 * ((pc0 + 1) & 1) + hh) & 3)) + 8 * (p4 & 1));
    const int vbase = cb + 4 * hh - cs;
    const unsigned tbase = (unsigned)(NA_TBL + (64 + 15 + cb + 4 * hh - qc) * 4);
    const float qsc = 0.125f * LOG2E;
#define NA_STAGE(buf, krow) do { const size_t go_ = (size_t)(krow) * 64 * DIN; LAS unsigned char* Bw_ = L + (buf) * RT_BUF + wave * 1024; \
        __builtin_amdgcn_global_load_lds((const unsigned*)(kg + go_ + kgoff), (LAS unsigned*)(Bw_), 16, 0, 0); \
        __builtin_amdgcn_global_load_lds((const unsigned*)(vg + go_ + vgoff), (LAS unsigned*)(Bw_ + RT_V), 16, 0, 0); } while (0)
    for (;;) {
        const int it = q_next(qctr, (volatile LAS int*)(F.lds + MISC_OFF + 64), wave, lane); if (it >= nunits) break;
        const int rq = it % nrq, h = (it / nrq) % NA_H, s = it / (nrq * NA_H);
        const int row0 = s * S;
        int lane_u = lane; asm volatile("" : "+v"(lane_u));
        const int r = 4 * rq + 2 * rp + ((lane_u & 31) >> 4);
        int rs = r - 4; rs = rs < 0 ? 0 : (rs > rows - 8 ? rows - 8 : rs);
        int rw0 = 4 * rq + 2 * rp - 4; rw0 = rw0 < 0 ? 0 : (rw0 > rows - 8 ? rows - 8 : rw0);
        int rw1 = 4 * rq + 2 * rp - 3; rw1 = rw1 < 0 ? 0 : (rw1 > rows - 8 ? rows - 8 : rw1); rw1 += 8;
        int rlo = 4 * rq - 4; rlo = rlo < 0 ? 0 : (rlo > rows - 8 ? rows - 8 : rlo);
        int rhi = 4 * rq - 1; rhi = rhi < 0 ? 0 : (rhi > rows - 8 ? rows - 8 : rhi); rhi += 8;
        const int NTu = rhi - rlo;
        const bf16* kg = proj + (size_t)row0 * DIN + C_NK + h * 64;
        const bf16* vg = proj + (size_t)row0 * DIN + C_NV + h * 64;
        NA_STAGE(0, rlo); NA_STAGE(1, rlo + 1); NA_STAGE(2, rlo + 2);
        bf16x8 qf[4];
        { const bf16* qp = proj + (size_t)(row0 + r * 64 + 16 * blk + (lane_u & 15)) * DIN + C_NQ + h * 64 + (lane_u >> 5) * 8;
#pragma unroll
          for (int ds = 0; ds < 4; ++ds) { float f[8]; unpack8(*(const v4u*)(qp + ds * 16), f);
              v4u w; w.x = cvtpk(f[0] * qsc, f[1] * qsc); w.y = cvtpk(f[2] * qsc, f[3] * qsc); w.z = cvtpk(f[4] * qsc, f[5] * qsc); w.w = cvtpk(f[6] * qsc, f[7] * qsc);
              qf[ds] = __builtin_bit_cast(bf16x8, w); } }
        { const int tix = wave * 64 + lane_u;
          if (tix < 15 * 31) { const int dr = tix / 31, dc = tix % 31; *(LAS float*)(L + NA_TBL + (dr * NA_TROW + 64 + dc) * 4) = rpb[h * 15 * 31 + tix] * LOG2E; }
          for (int p = tix; p < 15 * NA_TROW; p += NTHREADS) { const int dc = p % NA_TROW - 64; if (!((unsigned)dc < 31u)) *(LAS float*)(L + NA_TBL + p * 4) = 0.f; } }
        const unsigned tra_lo = (unsigned)(uintptr_t)L + trlo, tra_hi = (unsigned)(uintptr_t)L + trhi;
        f32x16 O[2];
#pragma unroll
        for (int db = 0; db < 2; ++db)
#pragma unroll
            for (int rr = 0; rr < 16; ++rr) O[db][rr] = 0.f;
        float m = 0.f, l = 0.f;
        float madd[16];
        { int vb = vbase; asm volatile("" : "+v"(vb));
#pragma unroll
          for (int rr = 0; rr < 16; ++rr) madd[rr] = ((unsigned)(vb + (rr & 3) + 8 * (rr >> 2)) < 16u) ? 0.f : -3e30f; }
#pragma unroll 1
        for (int t4 = 0; t4 < NTu; t4 += RT_NBUF) {
#pragma unroll
          for (int tb_ = 0; tb_ < RT_NBUF; ++tb_) {
            const int t = t4 + tb_;
            if (t < NTu) {
            const int kr = rlo + t;
            const LAS unsigned char* B = L + tb_ * RT_BUF;
            if (t + 2 < NTu) asm volatile("s_waitcnt vmcnt(4)" ::: "memory"); else if (t + 1 < NTu) asm volatile("s_waitcnt vmcnt(2)" ::: "memory"); else asm volatile("s_waitcnt vmcnt(0)" ::: "memory");
            __builtin_amdgcn_s_barrier(); asm volatile("" ::: "memory");
            if (t + 3 < NTu) NA_STAGE((tb_ + 3) & 3, kr + 3);
            if (kr >= rw0 && kr < rw1) {
                bf16x8 kf[4];
#pragma unroll
                for (int ds = 0; ds < 4; ++ds) kf[ds] = *(const LAS bf16x8*)(B + (kaddr0 ^ (unsigned)(ds << 5)));
                s16x4 vl[2][2], vh[2][2];
#pragma unroll
                for (int db = 0; db < 2; ++db)
#pragma unroll
                    for (int ks = 0; ks < 2; ++ks) { TR_READ(vl[db][ks], tra_lo, tb_ * RT_BUF + 2048 * ks + 512 * db); TR_READ(vh[db][ks], tra_hi, tb_ * RT_BUF + 2048 * ks + 512 * db); }
                int drl = kr - r + 7; const float rm = ((unsigned)(kr - rs) < 8u ? 0.f : -3e30f) - m;
                drl = drl < 0 ? 0 : (drl > 14 ? 14 : drl);
                const unsigned trow = tbase + (unsigned)(drl * NA_TROW * 4);
                f32x16 a0;
#pragma unroll
                for (int rr = 0; rr < 16; ++rr) { const int ko = (rr & 3) + 8 * (rr >> 2); a0[rr] = (*(const LAS float*)(L + trow + ko * 4) + madd[rr]) + rm; }
                __builtin_amdgcn_sched_barrier(0); LGKM_WAIT(0); __builtin_amdgcn_sched_barrier(0);
#pragma unroll
                for (int ds = 0; ds < 4; ++ds) a0 = __builtin_amdgcn_mfma_f32_32x32x16_bf16(kf[ds], qf[ds], a0, 0, 0, 0);
                float ls = 0.f;
#pragma unroll
                for (int rr = 0; rr < 16; ++rr) { const float p0 = __builtin_amdgcn_exp2f(a0[rr]); ls += p0; a0[rr] = p0; }
                if (__builtin_expect(__any(ls > 65536.f), 0)) {
                    const int e_ = __builtin_amdgcn_frexp_expf(ls) - 1; const float dl = half_max((float)(e_ > 0 ? e_ : 0)), alpha = __builtin_amdgcn_exp2f(-dl);
                    m += dl; l *= alpha; ls *= alpha;
#pragma unroll
                    for (int rr = 0; rr < 16; ++rr) a0[rr] *= alpha;
#pragma unroll
                    for (int db = 0; db < 2; ++db)
#pragma unroll
                        for (int rr = 0; rr < 16; ++rr) O[db][rr] *= alpha; }
                l += ls;
                bf16x8 pf[2];
#pragma unroll
                for (int sI = 0; sI < 2; ++sI) { v4u w; w.x = cvtpk(a0[8 * sI], a0[8 * sI + 1]); w.y = cvtpk(a0[8 * sI + 2], a0[8 * sI + 3]); w.z = cvtpk(a0[8 * sI + 4], a0[8 * sI + 5]); w.w = cvtpk(a0[8 * sI + 6], a0[8 * sI + 7]);
                    pf[sI] = __builtin_bit_cast(bf16x8, w); }
#pragma unroll
                for (int ks = 0; ks < 2; ++ks)
#pragma unroll
                    for (int db = 0; db < 2; ++db) O[db] = __builtin_amdgcn_mfma_f32_32x32x16_bf16(VFRAG(vl[db][ks], vh[db][ks]), pf[ks], O[db], 0, 0, 0);
            }
            asm volatile("s_waitcnt lgkmcnt(0)" ::: "memory");
            }
          }
        }
        const float inv = 1.f / half_sum(l);
        const int hh_u = lane_u >> 5;
        bf16* op = mix + (size_t)(row0 + r * 64 + 16 * blk + (lane_u & 15)) * DM + MIX_NA + h * 64;
#pragma unroll
        for (int db = 0; db < 2; ++db)
#pragma unroll
            for (int rp = 0; rp < 2; ++rp)
                store_pair16(op + 32 * db + 16 * rp, hh_u, cvtpk(O[db][8 * rp] * inv, O[db][8 * rp + 1] * inv), cvtpk(O[db][8 * rp + 2] * inv, O[db][8 * rp + 3] * inv),
                                                            cvtpk(O[db][8 * rp + 4] * inv, O[db][8 * rp + 5] * inv), cvtpk(O[db][8 * rp + 6] * inv, O[db][8 * rp + 7] * inv));
    }
#undef NA_STAGE
}

struct Args { const float* in[20]; float* out; unsigned char* ws; };
__global__ void __launch_bounds__(NTHREADS, 2) fwd_kernel(Args args) {
    extern __shared__ __attribute__((aligned(16))) unsigned char lds[];
    Frame F;
    F.lds = (LAS unsigned char*)lds;
    F.tid = threadIdx.x; F.lane = F.tid & 63; F.wave = __builtin_amdgcn_readfirstlane(F.tid >> 6);
    F.G = gridDim.x; F.bx = blockIdx.x;
    unsigned char* ws = args.ws;
    for (int u = F.tid; u < (LDS_BYTES - LDSCTL_OFF) / 4; u += NTHREADS) ((LAS unsigned*)(F.lds + LDSCTL_OFF))[u] = 0u;
    __syncthreads();
    XcdBarrier bar = xcd_barrier_post((unsigned*)(ws + WS_CTL) + CW_BAR, (volatile LAS unsigned*)(F.lds + MISC_OFF) + 8, F.wave);
#define GRID_BAR() xcd_barrier(bar)
    const bool chunked = (gridDim.x & 7u) == 0u && gridDim.x >= 16u;
    if (chunked) (void)xcd_barrier_post((unsigned*)(ws + WS_HBAR) + (blockIdx.x & 7u) * 4096u, (volatile LAS unsigned*)(F.lds + MISC_OFF) + 12, F.wave, gridDim.x >> 3);
#define CHUNK_BAR() do { if ((Gv & 7) == 0 && Gv >= 16) { XcdBarrier hb_; hb_.bar = (unsigned*)(ws + WS_HBAR) + ((unsigned)bx & 7u) * 4096u; hb_.x = xb_xcc_id(); hb_.st = (volatile LAS unsigned*)(F.lds + MISC_OFF) + 12; \
        hb_.wave = F.wave; hb_.np = (unsigned)Gv >> 3; xcd_barrier(hb_); } else GRID_BAR(); } while (0)

    unsigned char* ob = (unsigned char*)args.out;
    bf16* W_in = (bf16*)(ws + WS_WIN); bf16* W_out = (bf16*)(ob + OUT_WOUT); bf16* W_up = (bf16*)(ws + WS_WUP); bf16* W_dn = (bf16*)(ob + OUT_WDN);
    bf16* XB = (bf16*)(ws + WS_H); bf16* MIXb = (bf16*)(ob + OUT_MIX); bf16* PROJ = (bf16*)(ws + WS_PROJ); bf16* ACT = (bf16*)(ws + WS_PROJ);
    float* EPb = (float*)(ws + WS_ACT); float* EAb = EPb + (size_t)(MT / 256) * 2 * DFF; float* EGb = EAb + (size_t)(MT / 256) * 2 * DFF;
    ssq_t* SS = (ssq_t*)(ws + WS_SS);

    transpose_matrix<false>(F, args.in[3], DM, DIN, W_in, args.in[2]);
    convert_rows(F, args.in[0], XB, SS, MG);
    convert_rows(F, args.in[1], XB + (size_t)MG * DM, SS + MG, MG);
    GRID_BAR();

    for (int l = 0; l < DEPTH; ++l) {
        int bx = (int)blockIdx.x, Gv = (int)gridDim.x; asm volatile("" : "+s"(bx), "+s"(Gv)); F.G = Gv; F.bx = bx;
        { pg8::Gemm gm{XB, W_in + (size_t)l * DIN * DM, MT, DIN, DM}; pg8::StaticOrder SO; SO.init(MT, DIN, F.G, bx);
          EpiBf16Scale E{PROJ, DIN, SS + (size_t)(2 * l) * MT};
          pg8::gemm_phase<EpiBf16Scale, pg8::StaticOrder, true, true>(F.lds + RING_OFF, gm, SO, E, F.wave); }
        GRID_BAR();
        {
            float li_v = 0.8f - 0.6f * expf(-0.3f * (float)l); asm volatile("" : "+v"(li_v));
            unsigned li_u = __builtin_amdgcn_readfirstlane(__float_as_uint(li_v)); asm volatile("" : "+s"(li_u));
            const float lam_init = __uint_as_float(li_u);
            const float d1 = wave_sum(args.in[8][l * 64 + F.lane] * args.in[9][l * 64 + F.lane]);
            const float d2 = wave_sum(args.in[10][l * 64 + F.lane] * args.in[11][l * 64 + F.lane]);
            const float lam = __uint_as_float(__builtin_amdgcn_readfirstlane(__float_as_uint(expf(d1) - expf(d2) + lam_init)));
            unsigned* qc = (unsigned*)(ws + WS_CTL) + CW_QUEUE + l * 6 * 64;
            const bf16* P1 = PROJ + (size_t)MG * DIN; bf16* M1 = MIXb + (size_t)MG * DM;
            if (l == 0) { const int nbg = Gv < NBG ? Gv : NBG;
              if (bx < nbg) { F.G = nbg;
                for (int l2 = 0; l2 < DEPTH; ++l2) {
                    if (l2 > 0) transpose_matrix<false>(F, args.in[3] + (size_t)l2 * DM * DIN, DM, DIN, W_in + (size_t)l2 * DIN * DM, args.in[2] + l2 * DM);
                    transpose_matrix<false>(F, args.in[13] + (size_t)l2 * DM * DM, DM, DM, W_out + (size_t)l2 * DM * DM, nullptr);
                    transpose_matrix<true>(F, args.in[15] + (size_t)l2 * DM * DUP, DM, DUP, W_up + (size_t)l2 * DUP * DM, args.in[14] + l2 * DM);
                    transpose_matrix<false>(F, args.in[18] + (size_t)l2 * DFF * DM, DFF, DM, W_dn + (size_t)l2 * DM * DFF, nullptr); }
                F.G = Gv; asm volatile("s_waitcnt vmcnt(0) lgkmcnt(0)" ::: "memory"); __syncthreads(); } }
            if (F.wave >= 4) __builtin_amdgcn_s_setprio(1);
            diff_mfma(F, P1, M1, args.in[12] + l * 768, lam, lam_init, 4096, 4, qc);
            diff_mfma(F, PROJ, MIXb, args.in[12] + l * 768, lam, lam_init, 2048, 8, qc + 64);
            ret_mfma(F, P1, M1, args.in[4] + l * 8, args.in[5] + l * 8, args.in[6] + l * 512, 4096, 4, qc + 128);
            ret_mfma(F, PROJ, MIXb, args.in[4] + l * 8, args.in[5] + l * 8, args.in[6] + l * 512, 2048, 8, qc + 192);
            na_mfma(F, P1, M1, args.in[7] + l * NA_H * 15 * 31, 4096, 4, qc + 256);
            na_mfma(F, PROJ, MIXb, args.in[7] + l * NA_H * 15 * 31, 2048, 8, qc + 320);
            __builtin_amdgcn_s_setprio(0);
        }
        GRID_BAR();
        { pg8::Gemm gm{MIXb, W_out + (size_t)l * DM * DM, MT, DM, DM}; pg8::StaticOrder SO; SO.init(MT, DM, F.G, bx);
          EpiResNorm E{XB, XB, SS + (size_t)(2 * l + 1) * MT, DM};
          pg8::gemm_phase<EpiResNorm, pg8::StaticOrder, true, true>(F.lds + RING_OFF, gm, SO, E, F.wave); }
        CHUNK_BAR();
        { pg8::Gemm gm{XB, W_up + (size_t)l * DUP * DM, MT, DUP, DM}; pg8::StaticOrder SO; SO.init(MT, DUP, F.G, bx);
          EpiUpConv E{ACT, SS + (size_t)(2 * l + 1) * MT, args.in[16] + (size_t)l * 3 * DFF, args.in[17] + (size_t)l * DFF, EPb, EAb, EGb, F.lds + RING_OFF};
          pg8::gemm_phase<EpiUpConv, pg8::StaticOrder, true, true>(F.lds + RING_OFF, gm, SO, E, F.wave); }
        CHUNK_BAR();
        { pg8::Gemm gm{ACT, W_dn + (size_t)l * DM * DFF, MT, DM, DFF}; pg8::StaticOrder SO; SO.init(MT, DM, F.G, bx);
          { frame_refresh(F); pg8::Unit uu; int lastpm = -1;
            for (int ui = 0; SO.next(ui, uu); ++ui) if (uu.pm != lastpm) { ffn_edge_fixup_panel(F, ACT, EPb, EAb, EGb, args.in[16] + (size_t)l * 3 * DFF, uu.pm < MG / 256 ? 2048 : 4096, uu.pm); lastpm = uu.pm; }
            asm volatile("s_waitcnt vmcnt(0)" ::: "memory"); __syncthreads(); }
          EpiResNorm E{XB, XB, SS + (size_t)(2 * l + 2) * MT, DM};
          pg8::gemm_phase<EpiResNorm, pg8::StaticOrder, true, true>(F.lds + RING_OFF, gm, SO, E, F.wave); }
        GRID_BAR();
    }
    final_norm_rows(F, XB, SS + (size_t)4 * MT, args.in[19], args.out, MT);
}

extern "C" void kernel_launch(void* const* d_in, const int* in_sizes, int n_in, void* d_out, int out_size, void* d_ws, size_t ws_size, hipStream_t stream) {
    static int grid = 0;
    if (grid == 0) {
        if (n_in != 20 || out_size != 2 * MG * DM || ws_size < WS_END) { fprintf(stderr, "kernel_launch: unexpected shapes / workspace (n_in %d out %d ws %zu); nothing launched\n", n_in, out_size, ws_size); grid = -1; return; }
        int dev = 0, cus = 0, per_cu = 0;
        if (hipGetDevice(&dev) != hipSuccess || hipDeviceGetAttribute(&cus, hipDeviceAttributeMultiprocessorCount, dev) != hipSuccess) { grid = -1; return; }
        if (hipFuncSetAttribute((const void*)fwd_kernel, hipFuncAttributeMaxDynamicSharedMemorySize, LDS_BYTES) != hipSuccess) { fprintf(stderr, "kernel_launch: hipFuncSetAttribute failed\n"); grid = -1; return; }
        if (hipOccupancyMaxActiveBlocksPerMultiprocessor(&per_cu, (const void*)fwd_kernel, NTHREADS, LDS_BYTES) != hipSuccess || per_cu < 1) { fprintf(stderr, "kernel_launch: occupancy query reports %d\n", per_cu); }
        (void)hipGetLastError();
        grid = cus;
    }
    if (grid < 0) return;
    if (hipMemsetAsync((char*)d_ws + WS_CTL, 0, CTL_ZERO_BYTES, stream) != hipSuccess) return;
    Args a{};
    for (int i = 0; i < 20; ++i) a.in[i] = (const float*)d_in[i];
    a.out = (float*)d_out; a.ws = (unsigned char*)d_ws;
    hipLaunchKernelGGL(fwd_kernel, dim3(grid), dim3(NTHREADS), LDS_BYTES, stream, a);
}
```

```cpp
#include <hip/hip_runtime.h>
#include <cstdio>
#include <cstdint>

__device__ __forceinline__ int lane_id_now() { int ln; asm volatile("v_mbcnt_lo_u32_b32 %0, -1, 0\n\tv_mbcnt_hi_u32_b32 %0, -1, %0" : "=v"(ln)); return ln; }
namespace pg8 {
#define PG8_LAS __attribute__((address_space(3)))
typedef unsigned short bf16_t;
typedef short bf16x8 __attribute__((ext_vector_type(8)));
typedef float f32x4 __attribute__((ext_vector_type(4)));
typedef unsigned u32x4 __attribute__((ext_vector_type(4)));
constexpr int BM = 256, BK = 64, HALF = 128, HTB = HALF * BK * 2  , STAGE_BYTES = 8 * HTB, NXCD = 8, WGM = 8;

__host__ __device__ __forceinline__ int lds_byte(int r, int c) { const int st = (r >> 4) * 2 + (c >> 5), rr = r & 15, cc = c & 31, ob = rr * 64 + cc * 2; return st * 1024 + (ob ^ (((ob >> 9) & 1) << 5)); }
__host__ __device__ __forceinline__ void stage_rc(int b, int& R, int& C) { const int st = b / 1024, sb = b % 1024, swz = sb ^ (((sb >> 9) & 1) << 5); R = (st >> 1) * 16 + swz / 64; C = (st & 1) * 32 + (swz % 64) / 2; }
__host__ __device__ __forceinline__ int perm32(int rho) { const int n = rho >> 4, i = rho & 15; return 8 * (i >> 2) + 4 * n + (i & 3); }

struct Unit { int pm, pn; };
struct Gemm { const bf16_t* A; const bf16_t* Bt; int M, N, K; };

struct StaticOrder {
    int nM, nN, nwg, G, c;
    __host__ __device__ void init(int M, int N, int G_, int c_) { nM = M / BM; nN = N / BM; nwg = nM * nN; G = G_; c = c_; }
    __host__ __device__ bool next(int i, Unit& u) const {
        const long L = (long)i * G + c; if (L >= nwg) return false;
        int wgid = (int)L; { const int q = nwg / NXCD, r = nwg % NXCD, xcd = wgid % NXCD, off = wgid / NXCD; wgid = (xcd < r ? xcd * (q + 1) : r * (q + 1) + (xcd - r) * q) + off; }
        const int nig = WGM * nN, gid = wgid / nig, fm = gid * WGM, gsz = (nM - fm) < WGM ? (nM - fm) : WGM;
        u.pm = fm + ((wgid % nig) % gsz); u.pn = (wgid % nig) / gsz; return true;
    }
    __device__ __forceinline__ void a_ready(const Unit&) const {}
    __device__ __forceinline__ void done(const Unit&) const {}
};

__device__ __forceinline__ unsigned cvt_pk_bf16(float lo, float hi) { unsigned r; asm volatile("v_cvt_pk_bf16_f32 %0, %1, %2" : "=v"(r) : "v"(lo), "v"(hi)); return r; }

template <class Epi, class Sched, bool ALIGN_EPI = false, bool SP2 = false>
__device__ __forceinline__ void gemm_phase(PG8_LAS unsigned char* lds, const Gemm g, const Sched& S, const Epi& E, int wave_id) {
    int tid_ = wave_id * 64 + lane_id_now();
    const int tid = tid_, wid = __builtin_amdgcn_readfirstlane(tid >> 6), lane = tid & 63, wr = wid >> 2, wc = wid & 3, fr = lane & 15, fq = lane >> 4;
    const int K = g.K, nt = K / BK;
    unsigned voffA[2], voffB[2];
#pragma unroll
    for (int i = 0; i < 2; ++i) { int R, C; stage_rc(tid * 16 + i * 8192, R, C); const int Rb = Epi::PERM ? ((R & ~31) + perm32(R & 31)) : R;
        voffA[i] = (unsigned)(R * K + C) * 2u; voffB[i] = (unsigned)(Rb * K + C) * 2u; }
    const size_t kstep = (size_t)(BK * 2);
    const size_t hstep = (size_t)HALF * K * 2;
    const size_t tstep = 2 * hstep;
    const unsigned ldsw = (unsigned)wid * 1024u;
    const int aoff = lds_byte(wr * 64 + fr, fq * 8), boff = lds_byte(wc * 32 + fr, fq * 8);
#define PG8_SA(b, h) (((b) * 2 + (h)) * HTB)
#define PG8_SB(b, h) ((4 + (b) * 2 + (h)) * HTB)
#define PG8_STAGE(bufoff, gbase, voff) do { _Pragma("unroll") for (int _i = 0; _i < 2; ++_i) \
        __builtin_amdgcn_global_load_lds((const unsigned*)((const char*)(gbase) + (voff)[_i]), (PG8_LAS unsigned*)(lds + (bufoff) + ldsw + _i * 8192), 16, 0, 0); } while (0)
#define PG8_LDA(dst, b, h) do { _Pragma("unroll") for (int m = 0; m < 4; ++m) _Pragma("unroll") for (int k = 0; k < 2; ++k) dst[m][k] = *(const PG8_LAS bf16x8*)(lds + PG8_SA(b, h) + aoff + m * 2048 + k * 1024); } while (0)
#define PG8_LDB(dst, b, h) do { _Pragma("unroll") for (int n = 0; n < 2; ++n) _Pragma("unroll") for (int k = 0; k < 2; ++k) dst[n][k] = *(const PG8_LAS bf16x8*)(lds + PG8_SB(b, h) + boff + n * 2048 + k * 1024); } while (0)
#define PG8_MMA(ai, bj, At, Bt) do { __builtin_amdgcn_s_setprio(1); _Pragma("unroll") for (int m = 0; m < 4; ++m) _Pragma("unroll") for (int n = 0; n < 2; ++n) _Pragma("unroll") for (int k = 0; k < 2; ++k) \
        acc[ai][bj][m][n] = __builtin_amdgcn_mfma_f32_16x16x32_bf16(Bt[n][k], At[m][k], acc[ai][bj][m][n], 0, 0, 0); __builtin_amdgcn_s_setprio(0); } while (0)
#define PG8_WAIT_V(n) asm volatile("s_waitcnt vmcnt(" #n ")" ::: "memory")
#define PG8_WAIT_L(n) asm volatile("s_waitcnt lgkmcnt(" #n ")" ::: "memory")
#define PG8_BAR __builtin_amdgcn_s_barrier()
#define PG8_SCHED __builtin_amdgcn_sched_barrier(0)
    Unit cur, nxt; int ui = 0;
    if (!S.next(0, cur)) return;
    f32x4 acc[2][2][4][2];
#pragma unroll
    for (int a = 0; a < 2; ++a)
#pragma unroll
        for (int b = 0; b < 2; ++b)
#pragma unroll
            for (int m = 0; m < 4; ++m)
#pragma unroll
                for (int n = 0; n < 2; ++n) acc[a][b][m][n] = (f32x4){0.f, 0.f, 0.f, 0.f};
    bf16x8 At[4][2], B0[2][2], B1[2][2];
    const char* cA = (const char*)g.A + (size_t)cur.pm * tstep; const char* cB = (const char*)g.Bt + (size_t)cur.pn * tstep;
    S.a_ready(cur);
    if constexpr (SP2) {
        PG8_STAGE(PG8_SB(0, 0), cB, voffB); PG8_STAGE(PG8_SB(0, 1), cB + hstep, voffB); PG8_STAGE(PG8_SA(0, 0), cA, voffA); PG8_STAGE(PG8_SA(0, 1), cA + hstep, voffA);
        if (wr == 1) PG8_BAR;
        PG8_WAIT_V(2); PG8_BAR;
        PG8_STAGE(PG8_SB(1, 0), cB + kstep, voffB); PG8_STAGE(PG8_SA(1, 0), cA + kstep, voffA); PG8_STAGE(PG8_SB(1, 1), cB + hstep + kstep, voffB);
        PG8_WAIT_V(6); PG8_BAR;
    } else {
        PG8_STAGE(PG8_SB(0, 0), cB, voffB); PG8_STAGE(PG8_SA(0, 0), cA, voffA); PG8_STAGE(PG8_SB(0, 1), cB + hstep, voffB); PG8_STAGE(PG8_SA(0, 1), cA + hstep, voffA);
        if (wr == 1) PG8_BAR;
        PG8_WAIT_V(4); PG8_BAR;
        PG8_STAGE(PG8_SB(1, 0), cB + kstep, voffB); PG8_STAGE(PG8_SA(1, 0), cA + kstep, voffA); PG8_STAGE(PG8_SB(1, 1), cB + hstep + kstep, voffB);
        PG8_WAIT_V(6); PG8_BAR;
    }
    for (;;) {
        const bool has_next = S.next(ui + 1, nxt);
        const char* nA = has_next ? (const char*)g.A + (size_t)nxt.pm * tstep : cA; const char* nB = has_next ? (const char*)g.Bt + (size_t)nxt.pn * tstep : cB;
        for (int t = 0; t < nt; t += 2) {
            const bool last = (t == nt - 2);
            const char* a1 = cA + (size_t)(t + 1) * kstep;
            const char* a2 = last ? nA : cA + (size_t)(t + 2) * kstep; const char* b2 = last ? nB : cB + (size_t)(t + 2) * kstep;
            const char* a3 = a2 + kstep; const char* b3 = b2 + kstep;
            if (last && has_next) S.a_ready(nxt);
            if constexpr (SP2) {
            PG8_LDB(B0, 0, 0); PG8_LDB(B1, 0, 1); PG8_SCHED; PG8_LDA(At, 0, 0); PG8_STAGE(PG8_SA(1, 1), a1 + hstep, voffA);
            PG8_WAIT_V(8); PG8_WAIT_L(0); PG8_BAR; PG8_MMA(0, 0, At, B0); PG8_MMA(0, 1, At, B1); PG8_BAR; PG8_SCHED;
            PG8_LDA(At, 0, 1); PG8_STAGE(PG8_SB(0, 0), b2, voffB); PG8_STAGE(PG8_SB(0, 1), b2 + hstep, voffB); PG8_STAGE(PG8_SA(0, 0), a2, voffA);
            PG8_WAIT_V(8); PG8_WAIT_L(0); PG8_BAR; PG8_MMA(1, 0, At, B0); PG8_MMA(1, 1, At, B1); PG8_BAR; PG8_SCHED;
            PG8_LDB(B0, 1, 0); PG8_LDB(B1, 1, 1); PG8_SCHED; PG8_LDA(At, 1, 0); PG8_STAGE(PG8_SA(0, 1), a2 + hstep, voffA);
            PG8_WAIT_V(8); PG8_WAIT_L(0); PG8_BAR; PG8_MMA(0, 0, At, B0); PG8_MMA(0, 1, At, B1); PG8_BAR; PG8_SCHED;
            PG8_LDA(At, 1, 1); PG8_STAGE(PG8_SB(1, 0), b3, voffB); PG8_STAGE(PG8_SB(1, 1), b3 + hstep, voffB); PG8_STAGE(PG8_SA(1, 0), a3, voffA);
            PG8_WAIT_V(8); PG8_WAIT_L(0); PG8_BAR; PG8_MMA(1, 0, At, B0); PG8_MMA(1, 1, At, B1); PG8_BAR; PG8_SCHED;
            } else {
            PG8_LDB(B0, 0, 0); PG8_SCHED; PG8_LDA(At, 0, 0); PG8_STAGE(PG8_SA(1, 1), a1 + hstep, voffA);
            PG8_WAIT_L(8); PG8_BAR; PG8_WAIT_L(0); PG8_MMA(0, 0, At, B0); PG8_BAR; PG8_SCHED;
            PG8_LDB(B1, 0, 1); PG8_STAGE(PG8_SB(0, 0), b2, voffB);
            PG8_BAR; PG8_WAIT_L(0); PG8_MMA(0, 1, At, B1); PG8_BAR;
            PG8_LDA(At, 0, 1); PG8_STAGE(PG8_SA(0, 0), a2, voffA);
            PG8_BAR; PG8_WAIT_L(0); PG8_MMA(1, 0, At, B0); PG8_BAR; PG8_SCHED;
            PG8_STAGE(PG8_SB(0, 1), b2 + hstep, voffB);
            PG8_WAIT_V(6); PG8_BAR; PG8_MMA(1, 1, At, B1); PG8_BAR;
            PG8_LDB(B0, 1, 0); PG8_SCHED; PG8_LDA(At, 1, 0); PG8_STAGE(PG8_SA(0, 1), a2 + hstep, voffA);
            PG8_WAIT_L(8); PG8_BAR; PG8_WAIT_L(0); PG8_MMA(0, 0, At, B0); PG8_BAR; PG8_SCHED;
            PG8_LDB(B1, 1, 1); PG8_STAGE(PG8_SB(1, 0), b3, voffB);
            PG8_BAR; PG8_WAIT_L(0); PG8_MMA(0, 1, At, B1); PG8_BAR;
            PG8_LDA(At, 1, 1); PG8_STAGE(PG8_SA(1, 0), a3, voffA);
            PG8_BAR; PG8_WAIT_L(0); PG8_MMA(1, 0, At, B0); PG8_BAR; PG8_SCHED;
            PG8_STAGE(PG8_SB(1, 1), b3 + hstep, voffB);
            PG8_WAIT_V(6); PG8_BAR; PG8_MMA(1, 1, At, B1); PG8_BAR;
            }
        }
        if constexpr (ALIGN_EPI) { if (wr == 0) PG8_BAR; }
        if constexpr (!Epi::AFTER_DRAIN) { E(acc, cur, wr, wc, fr, fq); S.done(cur); }
        if (!has_next) break;
#pragma unroll
        for (int a = 0; a < 2; ++a)
#pragma unroll
            for (int b = 0; b < 2; ++b)
#pragma unroll
                for (int m = 0; m < 4; ++m)
#pragma unroll
                    for (int n = 0; n < 2; ++n) acc[a][b][m][n] = (f32x4){0.f, 0.f, 0.f, 0.f};
        cur = nxt; cA = nA; cB = nB; ++ui;
        if constexpr (ALIGN_EPI) { if (wr == 1) PG8_BAR; }
    }
    PG8_WAIT_V(0);
    if constexpr (!ALIGN_EPI) { if (wr == 0) PG8_BAR; }
    PG8_BAR;
#undef PG8_SA
#undef PG8_SB
#undef PG8_STAGE
#undef PG8_LDA
#undef PG8_LDB
#undef PG8_MMA
#undef PG8_WAIT_V
#undef PG8_WAIT_L
#undef PG8_BAR
#undef PG8_SCHED
}
}

constexpr int NWAVES = 8, NTHREADS = NWAVES * 64;
constexpr int DM = 2048, DIN = 6656, DFF = 5632, DUP = 2 * DFF, DEPTH = 2;
constexpr int MG = 16384;
constexpr int RET_H = 8, NA_H = 12, DIFF_H = 6;
constexpr int C_RQ = 0, C_RK = 512, C_RV = 1024, C_RG = 1536, C_NQ = 2048, C_NK = 2816, C_NV = 3584, C_DQ = 4352, C_DK = 5120, C_DV = 5888;
constexpr int MIX_RET = 0, MIX_NA = 512, MIX_DIFF = 1280;
constexpr float NORM_EPS = 1e-6f;
constexpr float LOG2E = 1.4426950408889634f;

constexpr size_t MiB = 1u << 20;
constexpr size_t WS_CTL = 0, CTL_ZERO_BYTES = 2 * MiB;
constexpr int MT = 2 * MG;
constexpr size_t WS_WIN = 2 * MiB;
constexpr size_t WS_WUP = 54 * MiB;
constexpr size_t WS_H = 142 * MiB;
constexpr size_t WS_PROJ = 270 * MiB;
constexpr size_t WS_ACT = 686 * MiB;
constexpr size_t WS_END = 703 * MiB;
constexpr size_t OUT_MIX = 0;
constexpr size_t OUT_WOUT = 128 * MiB;
constexpr size_t OUT_WDN = 144 * MiB;
static_assert(OUT_WDN + 44 * MiB <= (size_t)MT * DM * 4 && WS_ACT + (size_t)3 * (MT / 256) * 2 * DFF * 4 <= WS_END && WS_PROJ + (size_t)MT * DIN * 2 <= WS_ACT, "workspace map");
constexpr int NBG = 48;
constexpr int CW_BAR = 4096;
constexpr int CW_QUEUE = 8192;
constexpr size_t WS_HBAR = 3 * MiB / 2;
constexpr size_t WS_SS = 65536;
static_assert(WS_SS + (size_t)2 * 5 * MG * 8 <= CTL_ZERO_BYTES && CTL_ZERO_BYTES <= WS_WIN && (CW_BAR + 3456) <= CW_QUEUE && (CW_QUEUE + 12 * 64) * 4 <= (int)WS_SS, "CTL map");

constexpr int RING_OFF = 0, RING_BYTES = 143360;
constexpr int LDSCTL_OFF = RING_BYTES, MISC_OFF = LDSCTL_OFF + 320;
constexpr int LDS_BYTES = 147456;

#define GAS __attribute__((address_space(1)))
#define LAS __attribute__((address_space(3)))
typedef unsigned short bf16;
typedef unsigned v4u __attribute__((ext_vector_type(4)));
typedef float f32x4 __attribute__((ext_vector_type(4)));
typedef GAS unsigned gu32;
#define RLX_AGENT __ATOMIC_RELAXED, __HIP_MEMORY_SCOPE_AGENT
#define LDS_WAIT() asm volatile("s_waitcnt lgkmcnt(0)" ::: "memory")
__device__ __forceinline__ unsigned f2bf(float f) { unsigned u = __builtin_bit_cast(unsigned, f); return (u + 0x7fffu + ((u >> 16) & 1u)) >> 16; }
__device__ __forceinline__ unsigned pk2(float lo, float hi) { return f2bf(lo) | (f2bf(hi) << 16); }
__device__ __forceinline__ float bflo(unsigned u) { return __uint_as_float(u << 16); }
__device__ __forceinline__ float bfhi(unsigned u) { return __uint_as_float(u & 0xffff0000u); }
__device__ __forceinline__ void unpack8(const v4u v, float* f) { f[0] = bflo(v.x); f[1] = bfhi(v.x); f[2] = bflo(v.y); f[3] = bfhi(v.y); f[4] = bflo(v.z); f[5] = bfhi(v.z); f[6] = bflo(v.w); f[7] = bfhi(v.w); }

#define XB_TMO      128
#define XB_XCNT(j)  (256  + 64 * (j))
#define XB_XSUB(j)  (1280 + 64 * (j))
#define XB_XGEN(j)  (2304 + 64 * (j))
#define XB_TOP      3328
#define XB_TOPGEN   3392
#define XCD_BAR_WORDS 3456
#define XB_SPIN_CAP (1u << 22)

__device__ __forceinline__ unsigned xb_ld(unsigned* p)              { return __hip_atomic_load(p, __ATOMIC_RELAXED, __HIP_MEMORY_SCOPE_AGENT); }
__device__ __forceinline__ unsigned xb_add(unsigned* p, unsigned v) { return __hip_atomic_fetch_add(p, v, __ATOMIC_RELAXED, __HIP_MEMORY_SCOPE_AGENT); }
__device__ __forceinline__ unsigned xb_xcc_id() { return (unsigned)__builtin_amdgcn_s_getreg((3 << 11) | 20) & 0xFu; }
#define XB_SPIN(cond, bar) do { unsigned _sp = 0; while (cond) { __builtin_amdgcn_s_sleep(1); \
    if ((++_sp & 255u) == 0u) { if (xb_ld(&(bar)[XB_TMO])) break; if (_sp > XB_SPIN_CAP) { __hip_atomic_store(&(bar)[XB_TMO], 1u, __ATOMIC_RELAXED, __HIP_MEMORY_SCOPE_AGENT); break; } } } } while (0)

struct XcdBarrier { unsigned* bar; unsigned x; volatile LAS unsigned* st; int wave; unsigned np; };

__device__ __forceinline__ XcdBarrier xcd_barrier_post(unsigned* bar, volatile LAS unsigned* st, int wave, unsigned np = 0u) {
    XcdBarrier b; b.bar = bar; b.x = xb_xcc_id(); b.st = st; b.wave = wave; b.np = np;
    if (threadIdx.x == 0) (void)xb_add(&bar[XB_XCNT(b.x)], 1u);
    return b;
}
__device__ __forceinline__ void xcd_barrier_complete(unsigned* bar, unsigned x, unsigned& nloc, unsigned& nx, unsigned np) {
    asm volatile("" : "+s"(x));
    const unsigned G = np ? np : gridDim.x * gridDim.y * gridDim.z;
    unsigned sum, cnt, mine, sp = 0u;
    for (;;) {
        sum = 0u; cnt = 0u; mine = 0u;
#pragma unroll
        for (unsigned j = 0; j < 16; ++j) { const unsigned c = xb_ld(&bar[XB_XCNT(j)]); sum += c; cnt += (c > 0u) ? 1u : 0u; mine = (j == x) ? c : mine; }
        if (sum == G) break;
        __builtin_amdgcn_s_sleep(1);
        if ((++sp & 255u) == 0u) { if (xb_ld(&bar[XB_TMO])) break; if (sp > XB_SPIN_CAP) { __hip_atomic_store(&bar[XB_TMO], 1u, __ATOMIC_RELAXED, __HIP_MEMORY_SCOPE_AGENT); break; } }
    }
    nloc = mine > 0u ? mine : 1u; nx = cnt > 0u ? cnt : 1u;
}
__device__ __forceinline__ void xcd_barrier(const XcdBarrier& b) {
    asm volatile("s_waitcnt vmcnt(0)" ::: "memory");
    __syncthreads();
    if (b.wave == 0 && lane_id_now() == 0) {
        unsigned* bar = b.bar; asm volatile("" : "+s"(bar));
        __builtin_amdgcn_s_waitcnt(0);
        unsigned nloc = b.st[0], nx = b.st[1];
        if (nloc == 0u) { xcd_barrier_complete(bar, b.x, nloc, nx, b.np); b.st[0] = nloc; b.st[1] = nx; }
        const unsigned old = xb_add(&bar[XB_XSUB(b.x)], 1u);
        const unsigned gen = old / nloc;
        if (old + 1u == (gen + 1u) * nloc) {
            __builtin_amdgcn_fence(__ATOMIC_RELEASE, "agent");
            asm volatile("s_waitcnt vmcnt(0)" ::: "memory");
            const unsigned og = xb_add(&bar[XB_TOP], 1u);
            const unsigned tg = og / nx;
            if (og + 1u == (tg + 1u) * nx) xb_add(&bar[XB_TOPGEN], 1u);
            else XB_SPIN(xb_ld(&bar[XB_TOPGEN]) == tg, bar);
            __builtin_amdgcn_fence(__ATOMIC_ACQUIRE, "agent");
            xb_add(&bar[XB_XGEN(b.x)], 1u);
            asm volatile("s_waitcnt vmcnt(0)" ::: "memory");
        } else {
            XB_SPIN(xb_ld(&bar[XB_XGEN(b.x)]) == gen, bar);
            __builtin_amdgcn_fence(__ATOMIC_ACQUIRE, "agent");
            asm volatile("s_waitcnt vmcnt(0)" ::: "memory");
        }
    }
    __syncthreads();
}

struct Frame {
    LAS unsigned char* lds;
    int tid, lane, wave;
    int G, bx;
};
__device__ __forceinline__ void frame_refresh(Frame& F) { int ln = lane_id_now();
    F.lane = ln; F.tid = F.wave * 64 + ln; }
template <int O> __device__ __forceinline__ float swz_xor(float v) { return __int_as_float(__builtin_amdgcn_ds_swizzle(__float_as_int(v), (O << 10) | 0x1f)); }
__device__ __forceinline__ void mul_inplace(float& x, float a) { asm volatile("v_mul_f32 %0, %0, %1" : "+v"(x) : "v"(a)); }
__device__ __forceinline__ int q_next(unsigned* ctr, volatile LAS int* slot, int wave, int lane) {
    __syncthreads();
    if (wave == 0 && lane == 0) *slot = (int)__hip_atomic_fetch_add(ctr, 1u, __ATOMIC_RELAXED, __HIP_MEMORY_SCOPE_AGENT);
    __syncthreads();
    return *slot;
}
__device__ __forceinline__ void store_pair16(bf16* rowp_k, int hh, unsigned ax, unsigned ay, unsigned bx, unsigned by) {
    auto r0 = __builtin_amdgcn_permlane32_swap(ax, bx, false, false); auto r1 = __builtin_amdgcn_permlane32_swap(ay, by, false, false);
    v4u w; w.x = r0[0]; w.y = r1[0]; w.z = r0[1]; w.w = r1[1];
    *(v4u*)(rowp_k + 8 * hh) = w;
}
__device__ __forceinline__ float wave_sum(float v) {
    v += swz_xor<1>(v); v += swz_xor<2>(v); v += swz_xor<4>(v); v += swz_xor<8>(v); v += swz_xor<16>(v);
    auto rr = __builtin_amdgcn_permlane32_swap(__float_as_uint(v), __float_as_uint(v), false, false);
    return __uint_as_float(rr[0]) + __uint_as_float(rr[1]);
}

template <bool UPMAP> __device__ __forceinline__ void p0_transpose_item(const float* W, int K, int N, bf16* WT, const float* gain, LAS float* scr, int item, int lane) {
    const int nblk = N / 64, kb = item / nblk, nb = item % nblk, k0 = 64 * kb, n0 = 64 * nb;
    const int lr = lane >> 4, lc = (lane & 15) * 4;
    f32x4 v[16]; float gsc[16];
#pragma unroll
    for (int i = 0; i < 16; ++i) { const int kk = 4 * i + lr; gsc[i] = gain ? gain[k0 + kk] : 1.f; v[i] = *(const GAS f32x4*)(W + (size_t)(k0 + kk) * N + n0 + lc); }
#pragma unroll
    for (int i = 0; i < 16; ++i) { const int kk = 4 * i + lr; LAS float* d = scr + kk * 65 + lc; d[0] = v[i].x * gsc[i]; d[1] = v[i].y * gsc[i]; d[2] = v[i].z * gsc[i]; d[3] = v[i].w * gsc[i]; }
    LDS_WAIT(); asm volatile("" ::: "memory");
    const int c = lane & 7;
    int r0 = n0;
    if (UPMAP) { const int isg = n0 >= DFF ? 1 : 0, chn = n0 - isg * DFF; r0 = 256 * (chn / 128) + 128 * isg + (chn % 128); }
#pragma unroll
    for (int j = 0; j < 8; ++j) { const int n = (lane >> 3) + 8 * j; const LAS float* sp = scr + (8 * c) * 65 + n;
        v4u o; o.x = pk2(sp[0 * 65], sp[1 * 65]); o.y = pk2(sp[2 * 65], sp[3 * 65]); o.z = pk2(sp[4 * 65], sp[5 * 65]); o.w = pk2(sp[6 * 65], sp[7 * 65]);
        *(GAS v4u*)(WT + (size_t)(r0 + n) * K + k0 + 8 * c) = o; }
    LDS_WAIT(); asm volatile("" ::: "memory");
}
template <bool UPMAP> __device__ __forceinline__ void transpose_matrix(Frame& F, const float* W, int K, int N, bf16* WT, const float* gain, int bx0 = 0, int nb = 0) {
    LAS float* scr = (LAS float*)(F.lds + RING_OFF + F.wave * 16640);
    const int gw = (F.bx - bx0) * NWAVES + F.wave, NGW = (nb ? nb : F.G) * NWAVES;
    const int nitems = (K / 64) * (N / 64);
    for (int it = gw; it < nitems; it += NGW) p0_transpose_item<UPMAP>(W, K, N, WT, gain, scr, it, F.lane);
}

typedef unsigned long long ssq_t;
__device__ __forceinline__ ssq_t ss_pack(float v) { const float hi = floorf(v); return ((ssq_t)(unsigned)hi << 24) + (ssq_t)(unsigned)((v - hi) * 16777216.f); }
__device__ __forceinline__ float ss_unpack(ssq_t q) { return __builtin_fmaf((float)(unsigned)(q >> 32), 256.f, (float)(unsigned)(q & 0xffffffffull) * (1.f / 16777216.f)); }
__device__ __forceinline__ void convert_rows(Frame& F, const float* xin, bf16* xb, ssq_t* ss, int nrows) {
    frame_refresh(F);
    const int gw = F.bx * NWAVES + F.wave, NGW = F.G * NWAVES;
    for (int m = gw; m < nrows; m += NGW) {
        const GAS f32x4* xr = (const GAS f32x4*)(xin + (size_t)m * DM) + F.lane;
        f32x4 v[8]; float sq = 0.f;
#pragma unroll
        for (int j = 0; j < 8; ++j) { v[j] = xr[64 * j]; sq += (v[j].x * v[j].x + v[j].y * v[j].y) + (v[j].z * v[j].z + v[j].w * v[j].w); }
        sq = wave_sum(sq);
        GAS unsigned long long* o8 = (GAS unsigned long long*)(xb + (size_t)m * DM) + F.lane;
#pragma unroll
        for (int j = 0; j < 8; ++j) o8[64 * j] = (unsigned long long)pk2(v[j].x, v[j].y) | ((unsigned long long)pk2(v[j].z, v[j].w) << 32);
        if (F.lane == 0) ss[m] = ss_pack(sq);
    }
}
__device__ __forceinline__ void final_norm_rows(Frame& F, const bf16* xb, const ssq_t* ss, const float* w, float* out, int nrows, int bx0 = 0, int nb = 0) {
    frame_refresh(F);
    const int gw = (F.bx - bx0) * NWAVES + F.wave, NGW = (nb ? nb : F.G) * NWAVES;
    for (int m = gw; m < nrows; m += NGW) {
        const float rstd = 1.f / sqrtf(ss_unpack(ss[m]) * (1.f / DM) + NORM_EPS);
#pragma unroll
        for (int j = 0; j < 4; ++j) { const int c0 = (64 * j + F.lane) * 8; float f[8]; unpack8(*(const GAS v4u*)(xb + (size_t)m * DM + c0), f);
            const f32x4 g0 = *(const GAS f32x4*)(w + c0), g1 = *(const GAS f32x4*)(w + c0 + 4);
            GAS f32x4* o = (GAS f32x4*)(out + (size_t)m * DM + c0);
            o[0] = (f32x4){f[0] * rstd * g0.x, f[1] * rstd * g0.y, f[2] * rstd * g0.z, f[3] * rstd * g0.w};
            o[1] = (f32x4){f[4] * rstd * g1.x, f[5] * rstd * g1.y, f[6] * rstd * g1.z, f[7] * rstd * g1.w}; }
    }
}

struct EpiBf16Scale {
    static constexpr bool PERM = true, AFTER_DRAIN = false;
    bf16* O; int ldc; const ssq_t* ss;
    __device__ __forceinline__ void operator()(const pg8::f32x4 (&acc)[2][2][4][2], const pg8::Unit& u, int wr, int wc, int fr, int fq) const {
        const int row0 = u.pm * 256 + wr * 64 + fr; const int col0 = u.pn * 256 + wc * 32 + 8 * fq;
#pragma unroll
        for (int ai = 0; ai < 2; ++ai)
#pragma unroll
            for (int m = 0; m < 4; ++m) { const int row = row0 + ai * 128 + m * 16; bf16* rowp = O + (size_t)row * ldc + col0;
                const float rstd = __builtin_amdgcn_rsqf(ss_unpack(ss[row]) * (1.f / DM) + NORM_EPS);
#pragma unroll
                for (int bj = 0; bj < 2; ++bj) { const pg8::f32x4 v0 = acc[ai][bj][m][0] * rstd, v1 = acc[ai][bj][m][1] * rstd;
                    v4u w; w.x = pg8::cvt_pk_bf16(v0[0], v0[1]); w.y = pg8::cvt_pk_bf16(v0[2], v0[3]); w.z = pg8::cvt_pk_bf16(v1[0], v1[1]); w.w = pg8::cvt_pk_bf16(v1[2], v1[3]);
                    *(v4u*)(rowp + bj * 128) = w; } }
    }
};
struct EpiResNorm {
    static constexpr bool PERM = true, AFTER_DRAIN = false;
    const bf16* Xin; bf16* XB; ssq_t* ss; int ldc;
    __device__ __forceinline__ void operator()(const pg8::f32x4 (&acc)[2][2][4][2], const pg8::Unit& u, int wr, int wc, int fr, int fq) const {
        const int row0 = u.pm * 256 + wr * 64 + fr; const int col0 = u.pn * 256 + wc * 32 + 8 * fq;
#pragma unroll
        for (int ai = 0; ai < 2; ++ai)
#pragma unroll
            for (int m = 0; m < 4; ++m) { const int row = row0 + ai * 128 + m * 16; const size_t off = (size_t)row * ldc + col0; float sq = 0.f;
#pragma unroll
                for (int bj = 0; bj < 2; ++bj) { pg8::f32x4 x0, x1;
                    { float f[8]; unpack8(*(const v4u*)(Xin + off + bj * 128), f); x0 = (pg8::f32x4){f[0], f[1], f[2], f[3]}; x1 = (pg8::f32x4){f[4], f[5], f[6], f[7]}; }
                    const pg8::f32x4 v0 = x0 + acc[ai][bj][m][0], v1 = x1 + acc[ai][bj][m][1];
                    v4u w; w.x = pg8::cvt_pk_bf16(v0[0], v0[1]); w.y = pg8::cvt_pk_bf16(v0[2], v0[3]); w.z = pg8::cvt_pk_bf16(v1[0], v1[1]); w.w = pg8::cvt_pk_bf16(v1[2], v1[3]);
                    *(v4u*)(XB + off + bj * 128) = w;
                    sq += (v0[0] * v0[0] + v0[1] * v0[1]) + (v0[2] * v0[2] + v0[3] * v0[3]) + (v1[0] * v1[0] + v1[1] * v1[1]) + (v1[2] * v1[2] + v1[3] * v1[3]); }
                sq += swz_xor<16>(sq); { auto rr = __builtin_amdgcn_permlane32_swap(__float_as_uint(sq), __float_as_uint(sq), false, false); sq = __uint_as_float(rr[0]) + __uint_as_float(rr[1]); }
                if (fq == 0) atomicAdd(ss + row, ss_pack(sq));
                if (m & 1) asm volatile("" ::: "memory"); }
    }
};

__device__ __forceinline__ float dpp_ror1(float v)  { return __int_as_float(__builtin_amdgcn_update_dpp(0, __float_as_int(v), 0x121, 0xf, 0xf, true)); }
__device__ __forceinline__ float dpp_ror15(float v) { return __int_as_float(__builtin_amdgcn_update_dpp(0, __float_as_int(v), 0x12f, 0xf, 0xf, true)); }
__device__ __forceinline__ float dpp_shr1(float old, float v) { return __int_as_float(__builtin_amdgcn_update_dpp(__float_as_int(old), __float_as_int(v), 0x111, 0xf, 0xf, false)); }
__device__ __forceinline__ float dpp_shl1(float old, float v) { return __int_as_float(__builtin_amdgcn_update_dpp(__float_as_int(old), __float_as_int(v), 0x101, 0xf, 0xf, false)); }
__device__ __forceinline__ float gelu_tanh_fast(float x) { const float arg = x * fmaf(x * x, -0.102943239f, -2.302208198f); return x * __builtin_amdgcn_rcpf(1.f + __builtin_amdgcn_exp2f(arg)); }
constexpr int HALO_OFF = 131072;
struct EpiUpConv {
    static constexpr bool PERM = true, AFTER_DRAIN = false;
    bf16* ACT; const ssq_t* ss; const float* cw; const float* cb; float* EP; float* EA; float* EG; LAS unsigned char* lds;
    __device__ __forceinline__ void operator()(pg8::f32x4 (&acc)[2][2][4][2], const pg8::Unit& u, int wr, int wc, int fr, int fq) const {
        const int row0 = u.pm * 256 + wr * 64 + fr; const int ch0 = u.pn * 128 + wc * 32 + 8 * fq;
        LAS float* H = (LAS float*)(lds + HALO_OFF);
#pragma unroll
        for (int ai = 0; ai < 2; ++ai)
#pragma unroll
            for (int m = 0; m < 4; ++m) { const float rstd = __builtin_amdgcn_rsqf(ss_unpack(ss[row0 + ai * 128 + m * 16]) * (1.f / DM) + NORM_EPS);
#pragma unroll
                for (int bj = 0; bj < 2; ++bj)
#pragma unroll
                    for (int n = 0; n < 2; ++n) acc[ai][bj][m][n] *= rstd; }
#pragma unroll
        for (int ai = 0; ai < 2; ++ai) { const int sl = 2 * ai + wr; LAS float* hp = H + (sl * 2) * 128 + wc * 32 + 8 * fq;
            if (fr == 0) { *(LAS pg8::f32x4*)(hp) = acc[ai][1][0][0]; *(LAS pg8::f32x4*)(hp + 4) = acc[ai][1][0][1]; }
            if (fr == 15) { *(LAS pg8::f32x4*)(hp + 128) = acc[ai][1][3][0]; *(LAS pg8::f32x4*)(hp + 128 + 4) = acc[ai][1][3][1]; } }
        asm volatile("s_waitcnt lgkmcnt(0)" ::: "memory"); __builtin_amdgcn_s_barrier(); asm volatile("" ::: "memory");
        const pg8::f32x4 zero4 = (pg8::f32x4){0.f, 0.f, 0.f, 0.f};
        pg8::f32x4 w0[2], w1[2], w2[2], bb[2];
#pragma unroll
        for (int n = 0; n < 2; ++n) { w0[n] = *(const pg8::f32x4*)(cw + ch0 + 4 * n); w1[n] = *(const pg8::f32x4*)(cw + DFF + ch0 + 4 * n); w2[n] = *(const pg8::f32x4*)(cw + 2 * DFF + ch0 + 4 * n); bb[n] = *(const pg8::f32x4*)(cb + ch0 + 4 * n); }
#pragma unroll
        for (int ai = 0; ai < 2; ++ai) { const int sl = 2 * ai + wr;
            pg8::f32x4 hu[2], hd[2];
#pragma unroll
            for (int n = 0; n < 2; ++n) { hu[n] = sl > 0 ? *(const LAS pg8::f32x4*)(H + ((sl - 1) * 2 + 1) * 128 + wc * 32 + 8 * fq + 4 * n) : zero4;
                                          hd[n] = sl < 3 ? *(const LAS pg8::f32x4*)(H + ((sl + 1) * 2) * 128 + wc * 32 + 8 * fq + 4 * n) : zero4; }
#pragma unroll
            for (int m = 0; m < 4; ++m) { const int row = row0 + ai * 128 + m * 16; float o[8]; float gcv[8];
#pragma unroll
                for (int n = 0; n < 2; ++n)
#pragma unroll
                    for (int e = 0; e < 4; ++e) { const float gv = acc[ai][1][m][n][e];
                        const float xu = (fr == 15) ? (m > 0 ? acc[ai][1][m > 0 ? m - 1 : 0][n][e] : hu[n][e]) : gv;
                        const float xd = (fr == 0) ? (m < 3 ? acc[ai][1][m < 3 ? m + 1 : 3][n][e] : hd[n][e]) : gv;
                        float gc = fmaf(w1[n][e], gv, bb[n][e]);
                        gc = fmaf(dpp_ror1(xu), w0[n][e], gc);
                        gc = fmaf(dpp_ror15(xd), w2[n][e], gc);
                        gcv[4 * n + e] = gc; }
#pragma unroll
                for (int k2 = 0; k2 < 4; ++k2) { typedef float f32x2v __attribute__((ext_vector_type(2)));
                    const f32x2v x = (f32x2v){gcv[2 * k2], gcv[2 * k2 + 1]}, av = (f32x2v){acc[ai][0][m][k2 >> 1][2 * (k2 & 1)], acc[ai][0][m][k2 >> 1][2 * (k2 & 1) + 1]};
                    const f32x2v arg = x * (x * x * (f32x2v){-0.102943239f, -0.102943239f} + (f32x2v){-2.302208198f, -2.302208198f});
                    const f32x2v dn = (f32x2v){__builtin_amdgcn_exp2f(arg.x), __builtin_amdgcn_exp2f(arg.y)} + (f32x2v){1.f, 1.f};
                    const f32x2v r = (x * av) * (f32x2v){__builtin_amdgcn_rcpf(dn.x), __builtin_amdgcn_rcpf(dn.y)};
                    o[2 * k2] = r.x; o[2 * k2 + 1] = r.y; }
                const bool etop = (sl == 0 && m == 0 && fr == 0), ebot = (sl == 3 && m == 3 && fr == 15);
                if (etop || ebot) { const size_t eo = ((size_t)u.pm * 2 + (ebot ? 1 : 0)) * DFF + ch0;
#pragma unroll
                    for (int n = 0; n < 2; ++n) { *(pg8::f32x4*)(EP + eo + 4 * n) = (pg8::f32x4){gcv[4 * n], gcv[4 * n + 1], gcv[4 * n + 2], gcv[4 * n + 3]};
                        *(pg8::f32x4*)(EA + eo + 4 * n) = acc[ai][0][m][n]; *(pg8::f32x4*)(EG + eo + 4 * n) = acc[ai][1][m][n]; }
                } else { v4u w; w.x = pg8::cvt_pk_bf16(o[0], o[1]); w.y = pg8::cvt_pk_bf16(o[2], o[3]); w.z = pg8::cvt_pk_bf16(o[4], o[5]); w.w = pg8::cvt_pk_bf16(o[6], o[7]);
                    *(v4u*)(ACT + (size_t)row * DFF + ch0) = w; }
            }
        }
    }
};
__device__ __forceinline__ void ffn_edge_fixup_panel(Frame& F, bf16* ACT, const float* EP, const float* EA, const float* EG, const float* cw, int S, int pm) {
    constexpr int NC4 = DFF / 4;
    for (int it = F.tid; it < 2 * NC4; it += NTHREADS) {
        const int c4 = (it % NC4) * 4, tbq = it / NC4;
        const int row = pm * 256 + (tbq ? 255 : 0);
        const size_t eo = ((size_t)pm * 2 + tbq) * DFF + c4;
        f32x4 gp = *(const f32x4*)(EP + eo); const f32x4 av = *(const f32x4*)(EA + eo);
        if (tbq == 0) { if (row % S != 0) { const f32x4 gn = *(const f32x4*)(EG + ((size_t)(pm - 1) * 2 + 1) * DFF + c4), w = *(const f32x4*)(cw + c4); gp = gp + gn * w; } }
        else { if ((row + 1) % S != 0) { const f32x4 gn = *(const f32x4*)(EG + ((size_t)(pm + 1) * 2) * DFF + c4), w = *(const f32x4*)(cw + 2 * DFF + c4); gp = gp + gn * w; } }
        const unsigned lo = pg8::cvt_pk_bf16(gelu_tanh_fast(gp.x) * av.x, gelu_tanh_fast(gp.y) * av.y), hi = pg8::cvt_pk_bf16(gelu_tanh_fast(gp.z) * av.z, gelu_tanh_fast(gp.w) * av.w);
        *(unsigned long long*)(ACT + (size_t)row * DFF + c4) = (unsigned long long)lo | ((unsigned long long)hi << 32);
    }
}
typedef short bf16x8 __attribute__((ext_vector_type(8)));
typedef float f32x16 __attribute__((ext_vector_type(16)));
typedef short s16x4 __attribute__((ext_vector_type(4)));
typedef short v4i16_t __attribute__((ext_vector_type(4)));
__device__ __forceinline__ unsigned cvtpk(float lo, float hi) { unsigned r; asm("v_cvt_pk_bf16_f32 %0, %1, %2" : "=v"(r) : "v"(lo), "v"(hi)); return r; }
__device__ __forceinline__ float half_max(float v) { auto rr = __builtin_amdgcn_permlane32_swap(__float_as_uint(v), __float_as_uint(v), false, false); return fmaxf(__uint_as_float(rr[0]), __uint_as_float(rr[1])); }
__device__ __forceinline__ float half_sum(float v) { auto rr = __builtin_amdgcn_permlane32_swap(__float_as_uint(v), __float_as_uint(v), false, false); return __uint_as_float(rr[0]) + __uint_as_float(rr[1]); }
#define TR_READ(dst, addr, imm) asm volatile("ds_read_b64_tr_b16 %0, %1 offset:%c2" : "=&v"(dst) : "v"(addr), "i"(imm) : "memory")
#define LGKM_WAIT(n) asm volatile("s_waitcnt lgkmcnt(" #n ")" ::: "memory")
#define VFRAG(lo, hi) ((bf16x8){(lo)[0], (lo)[1], (lo)[2], (lo)[3], (hi)[0], (hi)[1], (hi)[2], (hi)[3]})

constexpr int DF_KMAP = 8192, DF_V = 16384, DF_BUF = 32768;
constexpr int DF_Q = 2 * DF_BUF, DF_QROW = 272;
static_assert(DF_Q + 8 * 32 * DF_QROW <= RING_BYTES, "diff attention LDS");
__device__ __forceinline__ void diff_mfma(Frame& F, const bf16* proj, bf16* mix, const float* nw, float lam, float lam_init, int S, int nseq, unsigned* qctr) {
    frame_refresh(F);
    const int lane = F.lane, wave = F.wave, q32 = lane & 31, hh = lane >> 5;
    LAS unsigned char* L = F.lds + RING_OFF;
    const int nqb = S / 256, nunits = nseq * DIFF_H * nqb, NT = S / 64;
    const unsigned kaddr0 = (unsigned)(q32 * 128 + (((((q32 >> 1) & 7) >> 1) << 1 | (hh ^ ((q32 >> 1) & 1))) * 16));
    const int i16 = lane & 15, q4 = i16 >> 2, p4 = i16 & 3, g1 = (lane >> 4) & 1;
    const unsigned trlo = (unsigned)(DF_V + 64 * (4 * hh + q4) + 16 * ((2 * g1 + (p4 >> 1)) ^ hh) + 8 * (p4 & 1));
    const unsigned trhi = (unsigned)(DF_V + 2048 + 64 * (4 * hh + q4) + 16 * ((2 * g1 + (p4 >> 1)) ^ ((2 + hh) & 3)) + 8 * (p4 & 1));
    const float sc2 = 0.125f * LOG2E;
#define DF_STAGE(buf, tile) do { const bf16* k0_ = kg + (size_t)(tile) * 64 * DIN; const bf16* k1_ = k0_ + 64; const bf16* v0_ = vg + (size_t)(tile) * 64 * DIN; const bf16* v1_ = v0_ + 32 * DIN; \
        unsigned ko_ = kgoffB, vo_ = vgoffB; asm volatile("" : "+s"(k0_), "+s"(k1_), "+s"(v0_), "+s"(v1_), "+v"(ko_), "+v"(vo_)); \
        LAS unsigned char* Bw_ = L + (buf) * DF_BUF + wave * 1024; \
        __builtin_amdgcn_global_load_lds((const unsigned*)((const char*)k0_ + ko_), (LAS unsigned*)(Bw_), 16, 0, 0); \
        __builtin_amdgcn_global_load_lds((const unsigned*)((const char*)k1_ + ko_), (LAS unsigned*)(Bw_ + DF_KMAP), 16, 0, 0); \
        __builtin_amdgcn_global_load_lds((const unsigned*)((const char*)v0_ + vo_), (LAS unsigned*)(Bw_ + DF_V), 16, 0, 0); \
        __builtin_amdgcn_global_load_lds((const unsigned*)((const char*)v1_ + vo_), (LAS unsigned*)(Bw_ + DF_V + 8192), 16, 0, 0); } while (0)
    for (;;) {
        const int lane_u = lane_id_now();
        const int it = q_next(qctr, (volatile LAS int*)(F.lds + MISC_OFF + 64), wave, lane_u); if (it >= nunits) break;
        const int qb = it % nqb, h = (it / nqb) % DIFF_H, s = it / (nqb * DIFF_H);
        const int row0 = s * S;
        const float nslope2 = __uint_as_float(__builtin_amdgcn_readfirstlane(__float_as_uint(-exp2f(-8.f * (float)(h + 1) / 6.f) * LOG2E)));
        const int ih = qb * 256 + wave * 32 + (lane_u & 31) - 4 * (lane_u >> 5);
        const int td = (qb * 256 + wave * 32) >> 6;
        const int kkey = 8 * wave + (lane_u >> 3);
        const unsigned kgoffB = (unsigned)(kkey * DIN + ((lane_u & 7) ^ ((kkey >> 1) & 7)) * 8) * 2u;
        unsigned vgoffB;
        { const int pv = wave, rowhi = pv >> 1, chhi = 2 * (pv & 1) + (lane_u >> 5), r7 = (lane_u & 31) >> 2, slot = lane_u & 3;
          const int x = (2 * (rowhi & 1) + (r7 >> 2)) & 3, ch = 4 * chhi + (slot ^ x), row = 8 * rowhi + r7; vgoffB = (unsigned)(row * DIN + ch * 8) * 2u; }
        const bf16* kg = proj + (size_t)row0 * DIN + C_DK + h * 128;
        const bf16* vg = proj + (size_t)row0 * DIN + C_DV + h * 128;
        DF_STAGE(0, 0);
        bf16x8 qf[2][4];
        { const bf16* qp = proj + (size_t)(row0 + qb * 256 + wave * 32 + (lane_u & 31)) * DIN + C_DQ + h * 128 + (lane_u >> 5) * 8;
#pragma unroll
          for (int c = 0; c < 2; ++c)
#pragma unroll
              for (int ds = 0; ds < 4; ++ds) { float f[8]; unpack8(*(const v4u*)(qp + c * 64 + ds * 16), f);
                  v4u w; w.x = cvtpk(f[0] * sc2, f[1] * sc2); w.y = cvtpk(f[2] * sc2, f[3] * sc2); w.z = cvtpk(f[4] * sc2, f[5] * sc2); w.w = cvtpk(f[6] * sc2, f[7] * sc2);
                  qf[c][ds] = __builtin_bit_cast(bf16x8, w); } }
        const unsigned tra_lo = (unsigned)(uintptr_t)L + trlo, tra_hi = (unsigned)(uintptr_t)L + trhi;
        f32x16 O[2][4];
#pragma unroll
        for (int c = 0; c < 2; ++c)
#pragma unroll
            for (int db = 0; db < 4; ++db)
#pragma unroll
                for (int r = 0; r < 16; ++r) O[c][db][r] = 0.f;
        float m = 0.f, l[2] = {0.f, 0.f};
        asm volatile("s_waitcnt vmcnt(0)" ::: "memory");
        __syncthreads();
#pragma unroll 1
        for (int t2 = 0; t2 < NT; t2 += 2) {
#pragma unroll
          for (int tb_ = 0; tb_ < 2; ++tb_) {
            const int t = t2 + tb_;
            const LAS unsigned char* B = L + tb_ * DF_BUF;
            if (t + 1 < NT) DF_STAGE(tb_ ^ 1, t + 1);
            const float nsS = __uint_as_float(__builtin_amdgcn_readfirstlane(__float_as_uint(t < td ? nslope2 : -nslope2)));
            const float ns8 = __uint_as_float(__builtin_amdgcn_readfirstlane(__float_as_uint(8.f * nsS)));
#pragma unroll
            for (int kb = 0; kb < 2; ++kb) {
                bf16x8 kf[2][4];
#pragma unroll
                for (int c = 0; c < 2; ++c)
#pragma unroll
                    for (int ds = 0; ds < 4; ++ds) kf[c][ds] = *(const LAS bf16x8*)(B + c * DF_KMAP + kb * 4096 + (kaddr0 ^ (unsigned)(ds << 5)));
                __builtin_amdgcn_sched_barrier(0);
                f32x16 bias;
                float tbk = (float)(ih - t * 64 - 32 * kb); asm volatile("" : "+v"(tbk));
                if (__builtin_expect(t != td, 1)) {
                    const float b0 = __builtin_fmaf(tbk, nsS, -m);
                    bias[0] = b0; bias[4] = b0 - ns8; bias[8] = __builtin_fmaf(-2.f, ns8, b0); bias[12] = bias[8] - ns8;
#pragma unroll
                    for (int j = 0; j < 4; ++j) { bias[4 * j + 1] = bias[4 * j] - nsS; bias[4 * j + 2] = __builtin_fmaf(-2.f, nsS, bias[4 * j]); bias[4 * j + 3] = __builtin_fmaf(-2.f, nsS, bias[4 * j + 1]); }
                } else {
#pragma unroll
                    for (int r = 0; r < 16; ++r) bias[r] = __builtin_fmaf(__builtin_fabsf(tbk - (float)((r & 3) + 8 * (r >> 2))), nslope2, -m);
                }
                __builtin_amdgcn_sched_barrier(0);
                f32x16 a[2];
#pragma unroll
                for (int c = 0; c < 2; ++c)
#pragma unroll
                    for (int ds = 0; ds < 4; ++ds) a[c] = __builtin_amdgcn_mfma_f32_32x32x16_bf16(kf[c][ds], qf[c][ds], ds == 0 ? bias : a[c], 0, 0, 0);
                s16x4 vl[4][2], vh[4][2];
#define DF_VREQ(db) do { _Pragma("unroll") for (int sI = 0; sI < 2; ++sI) { TR_READ(vl[db][sI], tra_lo, tb_ * DF_BUF + 4096 * (2 * kb + sI) + 512 * (db)); TR_READ(vh[db][sI], tra_hi, tb_ * DF_BUF + 4096 * (2 * kb + sI) + 512 * (db)); } } while (0)
#define DF_PV(db) do { _Pragma("unroll") for (int sI = 0; sI < 2; ++sI) { const bf16x8 vf = VFRAG(vl[db][sI], vh[db][sI]); \
                        O[0][db] = __builtin_amdgcn_mfma_f32_32x32x16_bf16(vf, pf[0][sI], O[0][db], 0, 0, 0); O[1][db] = __builtin_amdgcn_mfma_f32_32x32x16_bf16(vf, pf[1][sI], O[1][db], 0, 0, 0); } } while (0)
                __builtin_amdgcn_sched_barrier(0);
                DF_VREQ(0); DF_VREQ(1);
                bf16x8 pf[2][2];
                float ls[2] = {0.f, 0.f};
#pragma unroll
                for (int c = 0; c < 2; ++c)
#pragma unroll
                    for (int r = 0; r < 16; ++r) { const float p = __builtin_amdgcn_exp2f(a[c][r]); ls[c] += p; a[c][r] = p; }
                if (__builtin_expect(__any(fmaxf(ls[0], ls[1]) > 65536.f), 0)) {
                    const float lm = fmaxf(ls[0], ls[1]);
                    const int e_ = __builtin_amdgcn_frexp_expf(lm) - 1; const float dl = half_max((float)(e_ > 0 ? e_ : 0)), alpha = __builtin_amdgcn_exp2f(-dl);
                    m += dl;
#pragma unroll
                    for (int c = 0; c < 2; ++c) { l[c] *= alpha; ls[c] *= alpha;
#pragma unroll
                        for (int r = 0; r < 16; ++r) { float x_ = a[c][r]; mul_inplace(x_, alpha); a[c][r] = x_; }
#pragma unroll
                        for (int db = 0; db < 4; ++db)
#pragma unroll
                            for (int r = 0; r < 16; ++r) { float x_ = O[c][db][r]; mul_inplace(x_, alpha); O[c][db][r] = x_; } } }
#pragma unroll
                for (int c = 0; c < 2; ++c) { l[c] += ls[c];
#pragma unroll
                    for (int sI = 0; sI < 2; ++sI) { v4u w; w.x = cvtpk(a[c][8 * sI], a[c][8 * sI + 1]); w.y = cvtpk(a[c][8 * sI + 2], a[c][8 * sI + 3]); w.z = cvtpk(a[c][8 * sI + 4], a[c][8 * sI + 5]); w.w = cvtpk(a[c][8 * sI + 6], a[c][8 * sI + 7]);
                        pf[c][sI] = __builtin_bit_cast(bf16x8, w); }
                }
                __builtin_amdgcn_sched_barrier(0);
                LGKM_WAIT(4); __builtin_amdgcn_sched_barrier(0);
                DF_VREQ(2); __builtin_amdgcn_sched_barrier(0);
                DF_PV(0);   __builtin_amdgcn_sched_barrier(0);
                LGKM_WAIT(4); __builtin_amdgcn_sched_barrier(0);
                DF_VREQ(3); __builtin_amdgcn_sched_barrier(0);
                DF_PV(1);   __builtin_amdgcn_sched_barrier(0);
                LGKM_WAIT(4); __builtin_amdgcn_sched_barrier(0);
                DF_PV(2);   __builtin_amdgcn_sched_barrier(0);
                LGKM_WAIT(0); __builtin_amdgcn_sched_barrier(0);
                DF_PV(3);   __builtin_amdgcn_sched_barrier(0);
#undef DF_VREQ
#undef DF_PV
            }
            asm volatile("s_waitcnt vmcnt(0) lgkmcnt(0)" ::: "memory");
            __builtin_amdgcn_s_barrier(); asm volatile("" ::: "memory");
          }
        }
        const float inv0 = 1.f / half_sum(l[0]), inv1 = lam / half_sum(l[1]);
        float ss = 0.f;
#pragma unroll
        for (int db = 0; db < 4; ++db)
#pragma unroll
            for (int r = 0; r < 16; ++r) { const float o = O[0][db][r] * inv0 - O[1][db][r] * inv1; O[0][db][r] = o; ss += o * o; }
        ss = half_sum(ss);
        float li_ = __uint_as_float(__builtin_amdgcn_readfirstlane(__float_as_uint(lam_init))); asm volatile("" : "+s"(li_));
        const float rn = (1.f - li_) / sqrtf(ss * (1.f / 128.f) + NORM_EPS);
        const int lane_e = lane_id_now();
        const int hh_u = lane_e >> 5, i_u = qb * 256 + wave * 32 + (lane_e & 31);
        bf16* op = mix + (size_t)(row0 + i_u) * DM + MIX_DIFF + h * 128; const float* wp = nw + h * 128 + 4 * hh_u;
#pragma unroll
        for (int db = 0; db < 4; ++db)
#pragma unroll
            for (int rp = 0; rp < 2; ++rp) { unsigned w[2][2];
#pragma unroll
                for (int q_ = 0; q_ < 2; ++q_) { const int rg = 2 * rp + q_; const f32x4 g = *(const f32x4*)(wp + 32 * db + 8 * rg);
                    w[q_][0] = cvtpk(O[0][db][4 * rg] * rn * g.x, O[0][db][4 * rg + 1] * rn * g.y); w[q_][1] = cvtpk(O[0][db][4 * rg + 2] * rn * g.z, O[0][db][4 * rg + 3] * rn * g.w); }
                store_pair16(op + 32 * db + 16 * rp, hh_u, w[0][0], w[0][1], w[1][0], w[1][1]); }
    }
#undef DF_STAGE
}

constexpr int RT_V = 8192, RT_BUF = 16384, RT_NBUF = 4, RT_Q = RT_NBUF * RT_BUF, RT_QROW = 144;
constexpr int RT_SX = RT_Q + 8 * 32 * RT_QROW;
static_assert(RT_SX + 16384 + 64 * 144 <= RING_BYTES, "retention LDS");
__device__ __forceinline__ void ret_mfma(Frame& F, const bf16* proj, bf16* mix, const float* dec_f, const float* dec_b, const float* nw, int S, int nseq, unsigned* qctr) {
    frame_refresh(F);
    const int lane = F.lane, wave = F.wave, q32 = lane & 31, hh = lane >> 5;
    LAS unsigned char* L = F.lds + RING_OFF;
    const int nqb = S / 256, nunits = nseq * RET_H * nqb, NT = S / 64;
    const int kkey = 8 * wave + (lane >> 3);
    const unsigned kgoff = (unsigned)(kkey * DIN + ((lane & 7) ^ ((kkey >> 1) & 7)) * 8);
    unsigned vgoff;
    { const int chq = lane >> 5, r7 = (lane & 31) >> 2, slot = lane & 3, x = (2 * (wave & 1) + (r7 >> 2)) & 3; vgoff = (unsigned)((8 * wave + r7) * DIN + (4 * chq + (slot ^ x)) * 8); }
    const unsigned kaddr0 = (unsigned)(q32 * 128 + (((((q32 >> 1) & 7) >> 1) << 1 | (hh ^ ((q32 >> 1) & 1))) * 16));
    const int i16 = lane & 15, q4 = i16 >> 2, p4 = i16 & 3, g1 = (lane >> 4) & 1;
    const unsigned trlo = (unsigned)(RT_V + 64 * (4 * hh + q4) + 16 * ((2 * g1 + (p4 >> 1)) ^ hh) + 8 * (p4 & 1));
    const unsigned trhi = (unsigned)(RT_V + 1024 + 64 * (4 * hh + q4) + 16 * ((2 * g1 + (p4 >> 1)) ^ ((2 + hh) & 3)) + 8 * (p4 & 1));
#define RT_STAGE(buf, tile) do { const size_t go_ = (size_t)(tile) * 64 * DIN; LAS unsigned char* Bw_ = L + (buf) * RT_BUF + wave * 1024; \
        __builtin_amdgcn_global_load_lds((const unsigned*)(kg + go_ + kgoff), (LAS unsigned*)(Bw_), 16, 0, 0); \
        __builtin_amdgcn_global_load_lds((const unsigned*)(vg + go_ + vgoff), (LAS unsigned*)(Bw_ + RT_V), 16, 0, 0); } while (0)
    for (;;) {
        const int it = q_next(qctr, (volatile LAS int*)(F.lds + MISC_OFF + 64), wave, lane); if (it >= nunits) break;
        const int qb = it % nqb, h = (it / nqb) % RET_H, s = it / (nqb * RET_H);
        const int row0 = s * S, i = qb * 256 + wave * 32 + q32;
        const float lgf = __uint_as_float(__builtin_amdgcn_readfirstlane(__float_as_uint(-log2f(1.f + expf(-dec_f[h])))));
        const float lgb = __uint_as_float(__builtin_amdgcn_readfirstlane(__float_as_uint(-log2f(1.f + expf(-dec_b[h])))));
        int lane_u = lane; asm volatile("" : "+v"(lane_u));
        const bf16* kg = proj + (size_t)row0 * DIN + C_RK + h * 64;
        const bf16* vg = proj + (size_t)row0 * DIN + C_RV + h * 64;
        { const int nL_ = 4 * qb; const int t0 = (0 < nL_ + 4 ? 0 : NT - 1 - (0 - nL_ - 4)), t1 = (1 < nL_ + 4 ? 1 : NT - 1 - (1 - nL_ - 4)), t2 = (2 < nL_ + 4 ? 2 : NT - 1 - (2 - nL_ - 4));
          RT_STAGE(0, t0); RT_STAGE(1, t1); RT_STAGE(2, t2); }
        { LAS unsigned char* Qw = L + RT_Q + wave * (32 * RT_QROW);
#pragma unroll
          for (int k = 0; k < 4; ++k) { const int idx = k * 64 + lane_u, qrow = idx >> 3, qch = idx & 7; float f[8];
              unpack8(*(const v4u*)(proj + (size_t)(row0 + qb * 256 + wave * 32 + qrow) * DIN + C_RQ + h * 64 + qch * 8), f);
              v4u w; w.x = cvtpk(f[0] * 0.125f, f[1] * 0.125f); w.y = cvtpk(f[2] * 0.125f, f[3] * 0.125f); w.z = cvtpk(f[4] * 0.125f, f[5] * 0.125f); w.w = cvtpk(f[6] * 0.125f, f[7] * 0.125f);
              *(LAS v4u*)(Qw + qrow * RT_QROW + qch * 16) = w; } }
        const LAS unsigned char* Qr = L + RT_Q + wave * (32 * RT_QROW) + q32 * RT_QROW + hh * 16;
        const unsigned tra_lo = (unsigned)(uintptr_t)L + trlo, tra_hi = (unsigned)(uintptr_t)L + trhi;
        const int nL = 4 * qb, nSteps = NT;
#define RT_TILE_OF(st) ((st) < nL + 4 ? (st) : (NT - 1 - ((st) - nL - 4)))
        f32x16 O[2], St;
#pragma unroll
        for (int r = 0; r < 16; ++r) { O[0][r] = 0.f; O[1][r] = 0.f; St[r] = 0.f; }
        int lx = lane_u; asm volatile("" : "+v"(lx));
        const int hhx = lx >> 5, q4x = (lx & 15) >> 2, p4x = lx & 3, g1x = (lx >> 4) & 1;
        const int bd = wave & 1, be = (wave >> 1) & 1, kh = wave >> 2;
        const unsigned ka_lo = (unsigned)(uintptr_t)L + (unsigned)((4 * hhx + q4x) * 128 + (((4 * bd + 2 * g1x + (p4x >> 1)) ^ ((2 * hhx + (q4x >> 1)) & 7)) * 16) + 8 * (p4x & 1));
        const unsigned ka_hi = (unsigned)(uintptr_t)L + (unsigned)((8 + 4 * hhx + q4x) * 128 + (((4 * bd + 2 * g1x + (p4x >> 1)) ^ ((4 + 2 * hhx + (q4x >> 1)) & 7)) * 16) + 8 * (p4x & 1));
        float kfs[2][8];
#pragma unroll
        for (int sx = 0; sx < 2; ++sx)
#pragma unroll
            for (int j = 0; j < 8; ++j) kfs[sx][j] = __builtin_amdgcn_exp2f(lgf * (float)(63 - (16 * (2 * kh + sx) + (j < 4 ? 4 * hhx + j : 8 + 4 * hhx + (j - 4)))));
        const float gf64 = __builtin_amdgcn_exp2f(lgf * 64.f), gb64 = __builtin_amdgcn_exp2f(lgb * 64.f);
        const int iloc = wave * 32 + (lx & 31);
        LAS float* SXF = (LAS float*)(L + RT_SX);
        LAS unsigned char* SXB = L + RT_SX + 16384;
#define RT_SIDE_DONE(rowfac) do { \
            asm volatile("s_waitcnt lgkmcnt(0)" ::: "memory"); __builtin_amdgcn_s_barrier(); asm volatile("" ::: "memory"); \
            if (kh == 1) { _Pragma("unroll") for (int r = 0; r < 16; ++r) SXF[((wave & 3) * 16 + r) * 64 + lx] = St[r]; } \
            asm volatile("s_waitcnt lgkmcnt(0)" ::: "memory"); __builtin_amdgcn_s_barrier(); asm volatile("" ::: "memory"); \
            if (kh == 0) { _Pragma("unroll") for (int rg = 0; rg < 4; ++rg) { float v_[4]; \
                    _Pragma("unroll") for (int e_ = 0; e_ < 4; ++e_) v_[e_] = St[4 * rg + e_] + SXF[((wave & 3) * 16 + 4 * rg + e_) * 64 + lx]; \
                    *(LAS unsigned long long*)(SXB + (32 * be + (lx & 31)) * 144 + (32 * bd + 8 * rg + 4 * hhx) * 2) = (unsigned long long)cvtpk(v_[0], v_[1]) | ((unsigned long long)cvtpk(v_[2], v_[3]) << 32); } } \
            asm volatile("s_waitcnt lgkmcnt(0)" ::: "memory"); __builtin_amdgcn_s_barrier(); asm volatile("" ::: "memory"); \
            { f32x16 x0, x1; _Pragma("unroll") for (int r = 0; r < 16; ++r) { x0[r] = 0.f; x1[r] = 0.f; } \
              _Pragma("unroll") for (int ds = 0; ds < 4; ++ds) { const bf16x8 qv = *(const LAS bf16x8*)(Qr + ds * 32); \
                  const bf16x8 s0 = *(const LAS bf16x8*)(SXB + (lx & 31) * 144 + ds * 32 + hhx * 16), s1 = *(const LAS bf16x8*)(SXB + (32 + (lx & 31)) * 144 + ds * 32 + hhx * 16); \
                  x0 = __builtin_amdgcn_mfma_f32_32x32x16_bf16(s0, qv, x0, 0, 0, 0); x1 = __builtin_amdgcn_mfma_f32_32x32x16_bf16(s1, qv, x1, 0, 0, 0); } \
              const float rf_ = (rowfac); _Pragma("unroll") for (int r = 0; r < 16; ++r) { O[0][r] += x0[r] * rf_; O[1][r] += x1[r] * rf_; St[r] = 0.f; } } \
        } while (0)
#pragma unroll 1
        for (int st = 0; st < nSteps; ++st) {
            const int t = RT_TILE_OF(st);
            const unsigned boff = (unsigned)((st & 3) * RT_BUF);
            const LAS unsigned char* B = L + boff;
            const unsigned tl = tra_lo + boff, th = tra_hi + boff;
            if (st + 2 < nSteps) asm volatile("s_waitcnt vmcnt(4)" ::: "memory"); else if (st + 1 < nSteps) asm volatile("s_waitcnt vmcnt(2)" ::: "memory"); else asm volatile("s_waitcnt vmcnt(0)" ::: "memory");
            __builtin_amdgcn_s_barrier(); asm volatile("" ::: "memory");
            if (st + 3 < nSteps) { const int tn = RT_TILE_OF(st + 3); RT_STAGE((st + 3) & 3, tn); }
            const bool diag = (st >= nL) && (st < nL + 4);
            if (st == nL) {
                RT_SIDE_DONE(__builtin_amdgcn_exp2f(lgf * (float)(iloc + 1)));
#pragma unroll
                for (int sx = 0; sx < 2; ++sx)
#pragma unroll
                    for (int j = 0; j < 8; ++j) kfs[sx][j] = __builtin_amdgcn_exp2f(lgb * (float)(16 * (2 * kh + sx) + (j < 4 ? 4 * hhx + j : 8 + 4 * hhx + (j - 4))));
            }
            if (!diag) {
                const float g64 = st < nL ? gf64 : gb64;
#pragma unroll
                for (int r = 0; r < 16; ++r) St[r] *= g64;
                s16x4 kl[2], khh[2], vl2[2], vh2[2];
                const unsigned kal = ka_lo + boff, kah = ka_hi + boff, tlb = tl + 512u * (unsigned)be, thb = th + 512u * (unsigned)be;
#pragma unroll
                for (int sx = 0; sx < 2; ++sx) { if (kh == 0) { TR_READ(kl[sx], kal, 2048 * sx); TR_READ(khh[sx], kah, 2048 * sx); TR_READ(vl2[sx], tlb, 2048 * sx); TR_READ(vh2[sx], thb, 2048 * sx); }
                                                 else         { TR_READ(kl[sx], kal, 2048 * (2 + sx)); TR_READ(khh[sx], kah, 2048 * (2 + sx)); TR_READ(vl2[sx], tlb, 2048 * (2 + sx)); TR_READ(vh2[sx], thb, 2048 * (2 + sx)); } }
                LGKM_WAIT(0); __builtin_amdgcn_sched_barrier(0);
#pragma unroll
                for (int sx = 0; sx < 2; ++sx) {
                    unsigned kw[4];
#pragma unroll
                    for (int d2 = 0; d2 < 2; ++d2) { const unsigned ulo = ((unsigned)(unsigned short)kl[sx][2 * d2]) | ((unsigned)(unsigned short)kl[sx][2 * d2 + 1] << 16), uhi = ((unsigned)(unsigned short)khh[sx][2 * d2]) | ((unsigned)(unsigned short)khh[sx][2 * d2 + 1] << 16);
                        kw[d2] = cvtpk(bflo(ulo) * kfs[sx][2 * d2], bfhi(ulo) * kfs[sx][2 * d2 + 1]); kw[2 + d2] = cvtpk(bflo(uhi) * kfs[sx][4 + 2 * d2], bfhi(uhi) * kfs[sx][4 + 2 * d2 + 1]); }
                    const bf16x8 af = __builtin_bit_cast(bf16x8, (v4u){kw[0], kw[1], kw[2], kw[3]});
                    St = __builtin_amdgcn_mfma_f32_32x32x16_bf16(af, VFRAG(vl2[sx], vh2[sx]), St, 0, 0, 0); }
            } else {
            const float tb = (float)(i - t * 64 - 4 * hh);
            {
                f32x16 a0, a1;
#pragma unroll
                for (int r = 0; r < 16; ++r) { a0[r] = 0.f; a1[r] = 0.f; }
#pragma unroll
                for (int ds = 0; ds < 4; ++ds) { const bf16x8 qv = *(const LAS bf16x8*)(Qr + ds * 32);
                    const bf16x8 k0 = *(const LAS bf16x8*)(B + (kaddr0 ^ (unsigned)(ds << 5))), k1 = *(const LAS bf16x8*)(B + 4096 + (kaddr0 ^ (unsigned)(ds << 5)));
                    a0 = __builtin_amdgcn_mfma_f32_32x32x16_bf16(k0, qv, a0, 0, 0, 0); a1 = __builtin_amdgcn_mfma_f32_32x32x16_bf16(k1, qv, a1, 0, 0, 0); }
                s16x4 vl[2][4], vh[2][4];
                __builtin_amdgcn_sched_barrier(0);
#pragma unroll
                for (int db = 0; db < 2; ++db)
#pragma unroll
                    for (int ks = 0; ks < 4; ++ks) { TR_READ(vl[db][ks], tl, 2048 * ks + 512 * db); TR_READ(vh[db][ks], th, 2048 * ks + 512 * db); }
                __builtin_amdgcn_sched_barrier(0);
#pragma unroll
                for (int r = 0; r < 16; ++r) { const float t0 = tb - (float)((r & 3) + 8 * (r >> 2)), t1 = t0 - 32.f;
                    a0[r] *= __builtin_amdgcn_exp2f(fabsf(t0) * (t0 >= 0.f ? lgf : lgb)); a1[r] *= __builtin_amdgcn_exp2f(fabsf(t1) * (t1 >= 0.f ? lgf : lgb)); }
                bf16x8 pf[4];
#pragma unroll
                for (int sI = 0; sI < 2; ++sI) { v4u w; w.x = cvtpk(a0[8 * sI], a0[8 * sI + 1]); w.y = cvtpk(a0[8 * sI + 2], a0[8 * sI + 3]); w.z = cvtpk(a0[8 * sI + 4], a0[8 * sI + 5]); w.w = cvtpk(a0[8 * sI + 6], a0[8 * sI + 7]);
                    pf[sI] = __builtin_bit_cast(bf16x8, w);
                    v4u x; x.x = cvtpk(a1[8 * sI], a1[8 * sI + 1]); x.y = cvtpk(a1[8 * sI + 2], a1[8 * sI + 3]); x.z = cvtpk(a1[8 * sI + 4], a1[8 * sI + 5]); x.w = cvtpk(a1[8 * sI + 6], a1[8 * sI + 7]);
                    pf[2 + sI] = __builtin_bit_cast(bf16x8, x); }
                __builtin_amdgcn_sched_barrier(0); LGKM_WAIT(0); __builtin_amdgcn_sched_barrier(0);
#pragma unroll
                for (int ks = 0; ks < 4; ++ks)
#pragma unroll
                    for (int db = 0; db < 2; ++db) O[db] = __builtin_amdgcn_mfma_f32_32x32x16_bf16(VFRAG(vl[db][ks], vh[db][ks]), pf[ks], O[db], 0, 0, 0);
            }
            }
            asm volatile("s_waitcnt lgkmcnt(0)" ::: "memory");
        }
        RT_SIDE_DONE(__builtin_amdgcn_exp2f(lgb * (float)(256 - iloc)));
#undef RT_SIDE_DONE
#undef RT_TILE_OF
        float sm = 0.f;
#pragma unroll
        for (int db = 0; db < 2; ++db)
#pragma unroll
            for (int r = 0; r < 16; ++r) sm += O[db][r];
        const float mean = half_sum(sm) * (1.f / 64.f); float var = 0.f;
#pragma unroll
        for (int db = 0; db < 2; ++db)
#pragma unroll
            for (int r = 0; r < 16; ++r) { O[db][r] -= mean; var += O[db][r] * O[db][r]; }
        const float rstd = 1.f / sqrtf(half_sum(var) * (1.f / 64.f) + NORM_EPS);
        const int hh_u = lane_u >> 5, i_u = qb * 256 + wave * 32 + (lane_u & 31);
        const bf16* gp = proj + (size_t)(row0 + i_u) * DIN + C_RG + h * 64 + 4 * hh_u; bf16* op = mix + (size_t)(row0 + i_u) * DM + MIX_RET + h * 64; const float* wp = nw + h * 64 + 4 * hh_u;
#pragma unroll
        for (int db = 0; db < 2; ++db)
#pragma unroll
            for (int rp = 0; rp < 2; ++rp) { unsigned w[2][2];
#pragma unroll
              for (int q_ = 0; q_ < 2; ++q_) { const int rg = 2 * rp + q_; const f32x4 gw = *(const f32x4*)(wp + 32 * db + 8 * rg); const unsigned long long gv = *(const unsigned long long*)(gp + 32 * db + 8 * rg);
                const float g0 = bflo((unsigned)gv), g1_ = bfhi((unsigned)gv), g2 = bflo((unsigned)(gv >> 32)), g3 = bfhi((unsigned)(gv >> 32));
                const float y0 = O[db][4 * rg] * rstd * gw.x * (g0 / (1.f + __expf(-g0))), y1 = O[db][4 * rg + 1] * rstd * gw.y * (g1_ / (1.f + __expf(-g1_)));
                const float y2 = O[db][4 * rg + 2] * rstd * gw.z * (g2 / (1.f + __expf(-g2))), y3 = O[db][4 * rg + 3] * rstd * gw.w * (g3 / (1.f + __expf(-g3)));
                w[q_][0] = cvtpk(y0, y1); w[q_][1] = cvtpk(y2, y3); }
              store_pair16(op + 32 * db + 16 * rp, hh_u, w[0][0], w[0][1], w[1][0], w[1][1]); }
    }
#undef RT_STAGE
}

constexpr int NA_TBL = RT_Q + 8 * 32 * RT_QROW, NA_TROW = 160;
static_assert(NA_TBL + 15 * NA_TROW * 4 <= RING_BYTES, "NA LDS");
__device__ __forceinline__ void na_mfma(Frame& F, const bf16* proj, bf16* mix, const float* rpb, int S, int nseq, unsigned* qctr) {
    frame_refresh(F);
    const int lane = F.lane, wave = F.wave, q32 = lane & 31, hh = lane >> 5;
    LAS unsigned char* L = F.lds + RING_OFF;
    const int rows = S / 64, nrq = rows / 4, nunits = nseq * NA_H * nrq;
    const int kkey = 8 * wave + (lane >> 3);
    const unsigned kgoff = (unsigned)(kkey * DIN + ((lane & 7) ^ ((kkey >> 1) & 7)) * 8);
    unsigned vgoff;
    { const int chq = lane >> 5, r7 = (lane & 31) >> 2, slot = lane & 3, x = (2 * (wave & 1) + (r7 >> 2)) & 3; vgoff = (unsigned)((8 * wave + r7) * DIN + (4 * chq + (slot ^ x)) * 8); }
    const int blk = wave & 3, rp = wave >> 2, qc = 16 * blk + (q32 & 15);
    const int cb = (16 * blk - 8) < 0 ? 0 : ((16 * blk - 8) > 32 ? 32 : (16 * blk - 8));
    const int cs = (qc - 8) < 0 ? 0 : ((qc - 8) > 48 ? 48 : (qc - 8));
    const int kcol = cb + q32;
    const unsigned kaddr0 = (unsigned)(kcol * 128 + (((((kcol >> 1) & 7) >> 1) << 1 | (hh ^ ((kcol >> 1) & 1))) * 16));
    const int i16 = lane & 15, q4 = i16 >> 2, p4 = i16 & 3, g1 = (lane >> 4) & 1, pc0 = cb >> 3;
    const unsigned trlo = (unsigned)(RT_V + pc0 * 1024 + 64 * (4 * hh + q4) + 16 * ((2 * g1 + (p4 >> 1)) ^ ((2 * (pc0 & 1) + hh) & 3)) + 8 * (p4 & 1));
    const unsigned trhi = (unsigned)(RT_V + (pc0 + 1) * 1024 + 64 * (4 * hh + q4) + 16 * ((2 * g1 + (p4 >> 1)) ^ ((2 * ((pc0 + 1) & 1) + hh) & 3)) + 8 * (p4 & 1));
    const int vbase = cb + 4 * hh - cs;
    const unsigned tbase = (unsigned)(NA_TBL + (64 + 15 + cb + 4 * hh - qc) * 4);
    const float qsc = 0.125f * LOG2E;
#define NA_STAGE(buf, krow) do { const size_t go_ = (size_t)(krow) * 64 * DIN; LAS unsigned char* Bw_ = L + (buf) * RT_BUF + wave * 1024; \
        __builtin_amdgcn_global_load_lds((const unsigned*)(kg + go_ + kgoff), (LAS unsigned*)(Bw_), 16, 0, 0); \
        __builtin_amdgcn_global_load_lds((const unsigned*)(vg + go_ + vgoff), (LAS unsigned*)(Bw_ + RT_V), 16, 0, 0); } while (0)
    for (;;) {
        const int it = q_next(qctr, (volatile LAS int*)(F.lds + MISC_OFF + 64), wave, lane); if (it >= nunits) break;
        const int rq = it % nrq, h = (it / nrq) % NA_H, s = it / (nrq * NA_H);
        const int row0 = s * S;
        int lane_u = lane; asm volatile("" : "+v"(lane_u));
        const int r = 4 * rq + 2 * rp + ((lane_u & 31) >> 4);
        int rs = r - 4; rs = rs < 0 ? 0 : (rs > rows - 8 ? rows - 8 : rs);
        int rw0 = 4 * rq + 2 * rp - 4; rw0 = rw0 < 0 ? 0 : (rw0 > rows - 8 ? rows - 8 : rw0);
        int rw1 = 4 * rq + 2 * rp - 3; rw1 = rw1 < 0 ? 0 : (rw1 > rows - 8 ? rows - 8 : rw1); rw1 += 8;
        int rlo = 4 * rq - 4; rlo = rlo < 0 ? 0 : (rlo > rows - 8 ? rows - 8 : rlo);
        int rhi = 4 * rq - 1; rhi = rhi < 0 ? 0 : (rhi > rows - 8 ? rows - 8 : rhi); rhi += 8;
        const int NTu = rhi - rlo;
        const bf16* kg = proj + (size_t)row0 * DIN + C_NK + h * 64;
        const bf16* vg = proj + (size_t)row0 * DIN + C_NV + h * 64;
        NA_STAGE(0, rlo); NA_STAGE(1, rlo + 1); NA_STAGE(2, rlo + 2);
        bf16x8 qf[4];
        { const bf16* qp = proj + (size_t)(row0 + r * 64 + 16 * blk + (lane_u & 15)) * DIN + C_NQ + h * 64 + (lane_u >> 5) * 8;
#pragma unroll
          for (int ds = 0; ds < 4; ++ds) { float f[8]; unpack8(*(const v4u*)(qp + ds * 16), f);
              v4u w; w.x = cvtpk(f[0] * qsc, f[1] * qsc); w.y = cvtpk(f[2] * qsc, f[3] * qsc); w.z = cvtpk(f[4] * qsc, f[5] * qsc); w.w = cvtpk(f[6] * qsc, f[7] * qsc);
              qf[ds] = __builtin_bit_cast(bf16x8, w); } }
        { const int tix = wave * 64 + lane_u;
          if (tix < 15 * 31) { const int dr = tix / 31, dc = tix % 31; *(LAS float*)(L + NA_TBL + (dr * NA_TROW + 64 + dc) * 4) = rpb[h * 15 * 31 + tix] * LOG2E; }
          for (int p = tix; p < 15 * NA_TROW; p += NTHREADS) { const int dc = p % NA_TROW - 64; if (!((unsigned)dc < 31u)) *(LAS float*)(L + NA_TBL + p * 4) = 0.f; } }
        const unsigned tra_lo = (unsigned)(uintptr_t)L + trlo, tra_hi = (unsigned)(uintptr_t)L + trhi;
        f32x16 O[2];
#pragma unroll
        for (int db = 0; db < 2; ++db)
#pragma unroll
            for (int rr = 0; rr < 16; ++rr) O[db][rr] = 0.f;
        float m = 0.f, l = 0.f;
        float madd[16];
        { int vb = vbase; asm volatile("" : "+v"(vb));
#pragma unroll
          for (int rr = 0; rr < 16; ++rr) madd[rr] = ((unsigned)(vb + (rr & 3) + 8 * (rr >> 2)) < 16u) ? 0.f : -3e30f; }
#pragma unroll 1
        for (int t4 = 0; t4 < NTu; t4 += RT_NBUF) {
#pragma unroll
          for (int tb_ = 0; tb_ < RT_NBUF; ++tb_) {
            const int t = t4 + tb_;
            if (t < NTu) {
            const int kr = rlo + t;
            const LAS unsigned char* B = L + tb_ * RT_BUF;
            if (t + 2 < NTu) asm volatile("s_waitcnt vmcnt(4)" ::: "memory"); else if (t + 1 < NTu) asm volatile("s_waitcnt vmcnt(2)" ::: "memory"); else asm volatile("s_waitcnt vmcnt(0)" ::: "memory");
            __builtin_amdgcn_s_barrier(); asm volatile("" ::: "memory");
            if (t + 3 < NTu) NA_STAGE((tb_ + 3) & 3, kr + 3);
            if (kr >= rw0 && kr < rw1) {
                bf16x8 kf[4];
#pragma unroll
                for (int ds = 0; ds < 4; ++ds) kf[ds] = *(const LAS bf16x8*)(B + (kaddr0 ^ (unsigned)(ds << 5)));
                s16x4 vl[2][2], vh[2][2];
#pragma unroll
                for (int db = 0; db < 2; ++db)
#pragma unroll
                    for (int ks = 0; ks < 2; ++ks) { TR_READ(vl[db][ks], tra_lo, tb_ * RT_BUF + 2048 * ks + 512 * db); TR_READ(vh[db][ks], tra_hi, tb_ * RT_BUF + 2048 * ks + 512 * db); }
                int drl = kr - r + 7; const float rm = ((unsigned)(kr - rs) < 8u ? 0.f : -3e30f) - m;
                drl = drl < 0 ? 0 : (drl > 14 ? 14 : drl);
                const unsigned trow = tbase + (unsigned)(drl * NA_TROW * 4);
                f32x16 a0;
#pragma unroll
                for (int rr = 0; rr < 16; ++rr) { const int ko = (rr & 3) + 8 * (rr >> 2); a0[rr] = (*(const LAS float*)(L + trow + ko * 4) + madd[rr]) + rm; }
                __builtin_amdgcn_sched_barrier(0); LGKM_WAIT(0); __builtin_amdgcn_sched_barrier(0);
#pragma unroll
                for (int ds = 0; ds < 4; ++ds) a0 = __builtin_amdgcn_mfma_f32_32x32x16_bf16(kf[ds], qf[ds], a0, 0, 0, 0);
                float ls = 0.f;
#pragma unroll
                for (int rr = 0; rr < 16; ++rr) { const float p0 = __builtin_amdgcn_exp2f(a0[rr]); ls += p0; a0[rr] = p0; }
                if (__builtin_expect(__any(ls > 65536.f), 0)) {
                    const int e_ = __builtin_amdgcn_frexp_expf(ls) - 1; const float dl = half_max((float)(e_ > 0 ? e_ : 0)), alpha = __builtin_amdgcn_exp2f(-dl);
                    m += dl; l *= alpha; ls *= alpha;
#pragma unroll
                    for (int rr = 0; rr < 16; ++rr) a0[rr] *= alpha;
#pragma unroll
                    for (int db = 0; db < 2; ++db)
#pragma unroll
                        for (int rr = 0; rr < 16; ++rr) O[db][rr] *= alpha; }
                l += ls;
                bf16x8 pf[2];
#pragma unroll
                for (int sI = 0; sI < 2; ++sI) { v4u w; w.x = cvtpk(a0[8 * sI], a0[8 * sI + 1]); w.y = cvtpk(a0[8 * sI + 2], a0[8 * sI + 3]); w.z = cvtpk(a0[8 * sI + 4], a0[8 * sI + 5]); w.w = cvtpk(a0[8 * sI + 6], a0[8 * sI + 7]);
                    pf[sI] = __builtin_bit_cast(bf16x8, w); }
#pragma unroll
                for (int ks = 0; ks < 2; ++ks)
#pragma unroll
                    for (int db = 0; db < 2; ++db) O[db] = __builtin_amdgcn_mfma_f32_32x32x16_bf16(VFRAG(vl[db][ks], vh[db][ks]), pf[ks], O[db], 0, 0, 0);
            }
            asm volatile("s_waitcnt lgkmcnt(0)" ::: "memory");
            }
          }
        }
        const float inv = 1.f / half_sum(l);
        const int hh_u = lane_u >> 5;
        bf16* op = mix + (size_t)(row0 + r * 64 + 16 * blk + (lane_u & 15)) * DM + MIX_NA + h * 64;
#pragma unroll
        for (int db = 0; db < 2; ++db)
#pragma unroll
            for (int rp = 0; rp < 2; ++rp)
                store_pair16(op + 32 * db + 16 * rp, hh_u, cvtpk(O[db][8 * rp] * inv, O[db][8 * rp + 1] * inv), cvtpk(O[db][8 * rp + 2] * inv, O[db][8 * rp + 3] * inv),
                                                            cvtpk(O[db][8 * rp + 4] * inv, O[db][8 * rp + 5] * inv), cvtpk(O[db][8 * rp + 6] * inv, O[db][8 * rp + 7] * inv));
    }
#undef NA_STAGE
}

struct Args { const float* in[20]; float* out; unsigned char* ws; };
__global__ void __launch_bounds__(NTHREADS, 2) fwd_kernel(Args args) {
    extern __shared__ __attribute__((aligned(16))) unsigned char lds[];
    Frame F;
    F.lds = (LAS unsigned char*)lds;
    F.tid = threadIdx.x; F.lane = F.tid & 63; F.wave = __builtin_amdgcn_readfirstlane(F.tid >> 6);
    F.G = gridDim.x; F.bx = blockIdx.x;
    unsigned char* ws = args.ws;
    for (int u = F.tid; u < (LDS_BYTES - LDSCTL_OFF) / 4; u += NTHREADS) ((LAS unsigned*)(F.lds + LDSCTL_OFF))[u] = 0u;
    __syncthreads();
    XcdBarrier bar = xcd_barrier_post((unsigned*)(ws + WS_CTL) + CW_BAR, (volatile LAS unsigned*)(F.lds + MISC_OFF) + 8, F.wave);
#define GRID_BAR() xcd_barrier(bar)
    const bool chunked = (gridDim.x & 7u) == 0u && gridDim.x >= 16u;
    if (chunked) (void)xcd_barrier_post((unsigned*)(ws + WS_HBAR) + (blockIdx.x & 7u) * 4096u, (volatile LAS unsigned*)(F.lds + MISC_OFF) + 12, F.wave, gridDim.x >> 3);
#define CHUNK_BAR() do { if ((Gv & 7) == 0 && Gv >= 16) { XcdBarrier hb_; hb_.bar = (unsigned*)(ws + WS_HBAR) + ((unsigned)bx & 7u) * 4096u; hb_.x = xb_xcc_id(); hb_.st = (volatile LAS unsigned*)(F.lds + MISC_OFF) + 12; \
        hb_.wave = F.wave; hb_.np = (unsigned)Gv >> 3; xcd_barrier(hb_); } else GRID_BAR(); } while (0)

    unsigned char* ob = (unsigned char*)args.out;
    bf16* W_in = (bf16*)(ws + WS_WIN); bf16* W_out = (bf16*)(ob + OUT_WOUT); bf16* W_up = (bf16*)(ws + WS_WUP); bf16* W_dn = (bf16*)(ob + OUT_WDN);
    bf16* XB = (bf16*)(ws + WS_H); bf16* MIXb = (bf16*)(ob + OUT_MIX); bf16* PROJ = (bf16*)(ws + WS_PROJ); bf16* ACT = (bf16*)(ws + WS_PROJ);
    float* EPb = (float*)(ws + WS_ACT); float* EAb = EPb + (size_t)(MT / 256) * 2 * DFF; float* EGb = EAb + (size_t)(MT / 256) * 2 * DFF;
    ssq_t* SS = (ssq_t*)(ws + WS_SS);

    transpose_matrix<false>(F, args.in[3], DM, DIN, W_in, args.in[2]);
    convert_rows(F, args.in[0], XB, SS, MG);
    convert_rows(F, args.in[1], XB + (size_t)MG * DM, SS + MG, MG);
    GRID_BAR();

    for (int l = 0; l < DEPTH; ++l) {
        int bx = (int)blockIdx.x, Gv = (int)gridDim.x; asm volatile("" : "+s"(bx), "+s"(Gv)); F.G = Gv; F.bx = bx;
        { pg8::Gemm gm{XB, W_in + (size_t)l * DIN * DM, MT, DIN, DM}; pg8::StaticOrder SO; SO.init(MT, DIN, F.G, bx);
          EpiBf16Scale E{PROJ, DIN, SS + (size_t)(2 * l) * MT};
          pg8::gemm_phase<EpiBf16Scale, pg8::StaticOrder, true, true>(F.lds + RING_OFF, gm, SO, E, F.wave); }
        GRID_BAR();
        {
            float li_v = 0.8f - 0.6f * expf(-0.3f * (float)l); asm volatile("" : "+v"(li_v));
            unsigned li_u = __builtin_amdgcn_readfirstlane(__float_as_uint(li_v)); asm volatile("" : "+s"(li_u));
            const float lam_init = __uint_as_float(li_u);
            const float d1 = wave_sum(args.in[8][l * 64 + F.lane] * args.in[9][l * 64 + F.lane]);
            const float d2 = wave_sum(args.in[10][l * 64 + F.lane] * args.in[11][l * 64 + F.lane]);
            const float lam = __uint_as_float(__builtin_amdgcn_readfirstlane(__float_as_uint(expf(d1) - expf(d2) + lam_init)));
            unsigned* qc = (unsigned*)(ws + WS_CTL) + CW_QUEUE + l * 6 * 64;
            const bf16* P1 = PROJ + (size_t)MG * DIN; bf16* M1 = MIXb + (size_t)MG * DM;
            if (l == 0) { const int nbg = Gv < NBG ? Gv : NBG;
              if (bx < nbg) { F.G = nbg;
                for (int l2 = 0; l2 < DEPTH; ++l2) {
                    if (l2 > 0) transpose_matrix<false>(F, args.in[3] + (size_t)l2 * DM * DIN, DM, DIN, W_in + (size_t)l2 * DIN * DM, args.in[2] + l2 * DM);
                    transpose_matrix<false>(F, args.in[13] + (size_t)l2 * DM * DM, DM, DM, W_out + (size_t)l2 * DM * DM, nullptr);
                    transpose_matrix<true>(F, args.in[15] + (size_t)l2 * DM * DUP, DM, DUP, W_up + (size_t)l2 * DUP * DM, args.in[14] + l2 * DM);
                    transpose_matrix<false>(F, args.in[18] + (size_t)l2 * DFF * DM, DFF, DM, W_dn + (size_t)l2 * DM * DFF, nullptr); }
                F.G = Gv; asm volatile("s_waitcnt vmcnt(0) lgkmcnt(0)" ::: "memory"); __syncthreads(); } }
            if (F.wave >= 4) __builtin_amdgcn_s_setprio(1);
            diff_mfma(F, P1, M1, args.in[12] + l * 768, lam, lam_init, 4096, 4, qc);
            diff_mfma(F, PROJ, MIXb, args.in[12] + l * 768, lam, lam_init, 2048, 8, qc + 64);
            ret_mfma(F, P1, M1, args.in[4] + l * 8, args.in[5] + l * 8, args.in[6] + l * 512, 4096, 4, qc + 128);
            ret_mfma(F, PROJ, MIXb, args.in[4] + l * 8, args.in[5] + l * 8, args.in[6] + l * 512, 2048, 8, qc + 192);
            na_mfma(F, P1, M1, args.in[7] + l * NA_H * 15 * 31, 4096, 4, qc + 256);
            na_mfma(F, PROJ, MIXb, args.in[7] + l * NA_H * 15 * 31, 2048, 8, qc + 320);
            __builtin_amdgcn_s_setprio(0);
        }
        GRID_BAR();
        { pg8::Gemm gm{MIXb, W_out + (size_t)l * DM * DM, MT, DM, DM}; pg8::StaticOrder SO; SO.init(MT, DM, F.G, bx);
          EpiResNorm E{XB, XB, SS + (size_t)(2 * l + 1) * MT, DM};
          pg8::gemm_phase<EpiResNorm, pg8::StaticOrder, true, true>(F.lds + RING_OFF, gm, SO, E, F.wave); }
        CHUNK_BAR();
        { pg8::Gemm gm{XB, W_up + (size_t)l * DUP * DM, MT, DUP, DM}; pg8::StaticOrder SO; SO.init(MT, DUP, F.G, bx);
          EpiUpConv E{ACT, SS + (size_t)(2 * l + 1) * MT, args.in[16] + (size_t)l * 3 * DFF, args.in[17] + (size_t)l * DFF, EPb, EAb, EGb, F.lds + RING_OFF};
          pg8::gemm_phase<EpiUpConv, pg8::StaticOrder, true, true>(F.lds + RING_OFF, gm, SO, E, F.wave); }
        CHUNK_BAR();
        { pg8::Gemm gm{ACT, W_dn + (size_t)l * DM * DFF, MT, DM, DFF}; pg8::StaticOrder SO; SO.init(MT, DM, F.G, bx);
          { frame_refresh(F); pg8::Unit uu; int lastpm = -1;
            for (int ui = 0; SO.next(ui, uu); ++ui) if (uu.pm != lastpm) { ffn_edge_fixup_panel(F, ACT, EPb, EAb, EGb, args.in[16] + (size_t)l * 3 * DFF, uu.pm < MG / 256 ? 2048 : 4096, uu.pm); lastpm = uu.pm; }
            asm volatile("s_waitcnt vmcnt(0)" ::: "memory"); __syncthreads(); }
          EpiResNorm E{XB, XB, SS + (size_t)(2 * l + 2) * MT, DM};
          pg8::gemm_phase<EpiResNorm, pg8::StaticOrder, true, true>(F.lds + RING_OFF, gm, SO, E, F.wave); }
        GRID_BAR();
    }
    final_norm_rows(F, XB, SS + (size_t)4 * MT, args.in[19], args.out, MT);
}

extern "C" void kernel_launch(void* const* d_in, const int* in_sizes, int n_in, void* d_out, int out_size, void* d_ws, size_t ws_size, hipStream_t stream) {
    static int grid = 0;
    if (grid == 0) {
        if (n_in != 20 || out_size != 2 * MG * DM || ws_size < WS_END) { fprintf(stderr, "kernel_launch: unexpected shapes / workspace (n_in %d out %d ws %zu); nothing launched\n", n_in, out_size, ws_size); grid = -1; return; }
        int dev = 0, cus = 0, per_cu = 0;
        if (hipGetDevice(&dev) != hipSuccess || hipDeviceGetAttribute(&cus, hipDeviceAttributeMultiprocessorCount, dev) != hipSuccess) { grid = -1; return; }
        if (hipFuncSetAttribute((const void*)fwd_kernel, hipFuncAttributeMaxDynamicSharedMemorySize, LDS_BYTES) != hipSuccess) { fprintf(stderr, "kernel_launch: hipFuncSetAttribute failed\n"); grid = -1; return; }
        if (hipOccupancyMaxActiveBlocksPerMultiprocessor(&per_cu, (const void*)fwd_kernel, NTHREADS, LDS_BYTES) != hipSuccess || per_cu < 1) { fprintf(stderr, "kernel_launch: occupancy query reports %d\n", per_cu); }
        (void)hipGetLastError();
        grid = cus;
    }
    if (grid < 0) return;
    if (hipMemsetAsync((char*)d_ws + WS_CTL, 0, CTL_ZERO_BYTES, stream) != hipSuccess) return;
    Args a{};
    for (int i = 0; i < 20; ++i) a.in[i] = (const float*)d_in[i];
    a.out = (float*)d_out; a.ws = (unsigned char*)d_ws;
    hipLaunchKernelGGL(fwd_kernel, dim3(grid), dim3(NTHREADS), LDS_BYTES, stream, a);
}
```
